# Optimizing an MI355X kernel written in HIP

```python
import math
import jax, jax.numpy as jnp
from jax import lax
import numpy as np

D_MODEL = 2048
BATCH = 4
SEQ = 2048
DEPTH = 2

PLE_DIM = 256
HEAD_DIM = 64
GROUP_W = D_MODEL // 4
FOX_HEADS = GROUP_W // HEAD_DIM
DIFF_HEADS = GROUP_W // (2 * HEAD_DIM)
POOL_GROUPS = 4
POOL_CH = GROUP_W // POOL_GROUPS
POOL_WINDOWS = (2, 4, 8, 16)
SWA_HEADS = GROUP_W // HEAD_DIM
SWA_KV_HEADS = 2
SWA_GROUP = SWA_HEADS // SWA_KV_HEADS
SWA_WINDOW = 128
Q_BLOCK = 128
MIX_W = 4 * GROUP_W
IN_SIZES = (GROUP_W, GROUP_W, GROUP_W, FOX_HEADS,
            GROUP_W, GROUP_W, GROUP_W,
            GROUP_W,
            SWA_HEADS * HEAD_DIM, SWA_KV_HEADS * HEAD_DIM, SWA_KV_HEADS * HEAD_DIM)
IN_W = sum(IN_SIZES)
REL_BUCKETS = 32
REL_MAX_DIST = 128
REL_HEADS = DIFF_HEADS + SWA_HEADS
MOE_GROUPS = 4
EXPERTS_PER_GROUP = 4
N_EXPERTS = MOE_GROUPS * EXPERTS_PER_GROUP
TOP_K_IN_GROUP = 2
D_EXPERT = D_MODEL // 4
ALPHA = (2 * DEPTH) ** 0.25
BETA = (8 * DEPTH) ** -0.25
LN_EPS = 1e-5

kernel_name = "hymba_style_fox_diff_pool_swa_hmoe"


def _layer_norm(x, g, b):
    xf = x.astype(jnp.float32)
    mu = xf.mean(-1, keepdims=True)
    var = jnp.square(xf - mu).mean(-1, keepdims=True)
    return ((xf - mu) * lax.rsqrt(var + LN_EPS) * g + b).astype(x.dtype)


def _rms_norm(x, g):
    xf = x.astype(jnp.float32)
    return (xf * lax.rsqrt(jnp.mean(xf * xf, -1, keepdims=True) + LN_EPS) * g).astype(x.dtype)


def _t5_bucket(n):
    max_exact = REL_BUCKETS // 2
    nf = jnp.maximum(n, 1).astype(jnp.float32)
    large = max_exact + (jnp.log(nf / max_exact) / math.log(REL_MAX_DIST / max_exact)
                         * (REL_BUCKETS - max_exact)).astype(jnp.int32)
    large = jnp.minimum(large, REL_BUCKETS - 1)
    return jnp.where(n < max_exact, n, large)


def _split_cols(proj):
    bounds, acc = [], 0
    for s in IN_SIZES[:-1]:
        acc += s
        bounds.append(acc)
    return jnp.split(proj, bounds, axis=-1)


def _sweep(block_fn, seq):
    out = lax.map(block_fn, jnp.arange(seq // Q_BLOCK) * Q_BLOCK)
    nb, b, qb, h, dv = out.shape
    return jnp.moveaxis(out, 0, 1).reshape(b, nb * qb, h, dv)


def _forgetting_attention(q, k, v, f_logit):
    _, S_, _, d = q.shape
    c = jnp.cumsum(jax.nn.log_sigmoid(f_logit.astype(jnp.float32)), axis=1)
    c_t = jnp.transpose(c, (0, 2, 1))
    kpos = jnp.arange(S_)
    scale = d ** -0.5

    def block(start):
        qb = lax.dynamic_slice_in_dim(q, start, Q_BLOCK, axis=1)
        cq = lax.dynamic_slice_in_dim(c_t, start, Q_BLOCK, axis=2)
        logits = jnp.einsum('bqhd,bkhd->bhqk', qb, k, preferred_element_type=jnp.float32) * scale
        logits = logits + cq[..., :, None] - c_t[..., None, :]
        qpos = start + jnp.arange(Q_BLOCK)
        mask = kpos[None, :] <= qpos[:, None]
        probs = jax.nn.softmax(jnp.where(mask, logits, -jnp.inf), axis=-1)
        return jnp.einsum('bhqk,bkhd->bqhd', probs.astype(v.dtype), v)

    return _sweep(block, S_)


def _diff_attention(q, k, v, rel_bias, lam, lam_init, sub_g):
    _, S_, _, _, d = q.shape
    kpos = jnp.arange(S_)
    scale = d ** -0.5

    def block(start):
        qb = lax.dynamic_slice_in_dim(q, start, Q_BLOCK, axis=1)
        logits = jnp.einsum('bqhmd,bkhmd->bhmqk', qb, k, preferred_element_type=jnp.float32) * scale
        dist = (start + jnp.arange(Q_BLOCK))[:, None] - kpos[None, :]
        bias = jnp.transpose(rel_bias[jnp.maximum(dist, 0)], (2, 0, 1))
        logits = logits + bias[None, :, None].astype(jnp.float32)
        probs = jax.nn.softmax(jnp.where(dist >= 0, logits, -jnp.inf), axis=-1)
        attn = probs[:, :, 0] - lam * probs[:, :, 1]
        return jnp.einsum('bhqk,bkhe->bqhe', attn.astype(v.dtype), v)

    o = _sweep(block, S_)
    o = _rms_norm(o, sub_g) * (1.0 - lam_init)
    return o.reshape(o.shape[0], S_, -1)


def _pool_mixer(u, pool_w, pool_scale):
    B_, S_, C = u.shape
    uf = u.astype(jnp.float32)
    cs = jnp.pad(jnp.cumsum(uf, axis=1), ((0, 0), (1, 0), (0, 0)))
    win = jnp.repeat(jnp.array(POOL_WINDOWS, dtype=jnp.int32), POOL_CH)
    t1 = jnp.arange(1, S_ + 1, dtype=jnp.int32)[:, None]
    lo = jnp.maximum(t1 - win[None, :], 0)
    lower = jnp.take_along_axis(cs, jnp.broadcast_to(lo[None], (B_, S_, C)), axis=1)
    cnt = jnp.minimum(t1, win[None, :]).astype(jnp.float32)
    pooled = ((cs[:, 1:] - lower) / cnt - uf).astype(u.dtype).reshape(B_, S_, POOL_GROUPS, POOL_CH)
    y = jnp.einsum('bsgc,gcd->bsgd', pooled, pool_w).reshape(B_, S_, C)
    return y * pool_scale


def _sliding_window_attention(q, k, v, rel_bias, sinks):
    B_, S_, Hq, d = q.shape
    nb = S_ // Q_BLOCK
    qb = q.reshape(B_, nb, Q_BLOCK, SWA_KV_HEADS, SWA_GROUP, d)

    def windows(t):
        tp = jnp.pad(t, ((0, 0), (Q_BLOCK, 0), (0, 0), (0, 0))).reshape(B_, nb + 1, Q_BLOCK, SWA_KV_HEADS, d)
        return jnp.concatenate([tp[:, :-1], tp[:, 1:]], axis=2)

    kw, vw = windows(k), windows(v)
    logits = jnp.einsum('bnqhgd,bnkhd->bnhgqk', qb, kw, preferred_element_type=jnp.float32) * d ** -0.5
    rel = jnp.arange(Q_BLOCK)[:, None] + Q_BLOCK - jnp.arange(2 * Q_BLOCK)[None, :]
    in_win = (rel >= 0) & (rel < SWA_WINDOW)
    kvalid = (jnp.arange(nb)[:, None] * Q_BLOCK - Q_BLOCK + jnp.arange(2 * Q_BLOCK)[None, :]) >= 0
    mask = in_win[None] & kvalid[:, None, :]
    bias = jnp.transpose(rel_bias[jnp.clip(rel, 0, SWA_WINDOW - 1)], (2, 0, 1))
    bias = bias.reshape(SWA_KV_HEADS, SWA_GROUP, Q_BLOCK, 2 * Q_BLOCK).astype(jnp.float32)
    logits = jnp.where(mask[None, :, None, None], logits + bias[None, None], -jnp.inf)
    sink = sinks.astype(jnp.float32).reshape(SWA_KV_HEADS, SWA_GROUP)[None, None, :, :, None, None]
    m = jnp.maximum(logits.max(-1, keepdims=True), sink)
    e = jnp.exp(logits - m)
    probs = e / (e.sum(-1, keepdims=True) + jnp.exp(sink - m))
    out = jnp.einsum('bnhgqk,bnkhd->bnqhgd', probs.astype(v.dtype), vw)
    return out.reshape(B_, S_, Hq * d)


def _hier_moe(h, rg_w, rg_b, re_w, re_b, w_gate, w_up, w_down):
    B_, S_, D = h.shape
    t = h.reshape(-1, D)
    g_probs = jax.nn.softmax((t @ rg_w).astype(jnp.float32) + rg_b, axis=-1)
    g_sel = jnp.argmax(g_probs, axis=-1)
    g_p = jnp.take_along_axis(g_probs, g_sel[:, None], axis=-1)
    e_logits = ((t @ re_w).astype(jnp.float32) + re_b).reshape(-1, MOE_GROUPS, EXPERTS_PER_GROUP)
    e_in = jnp.take_along_axis(e_logits, g_sel[:, None, None], axis=1)[:, 0]
    top_v, top_i = lax.top_k(e_in, TOP_K_IN_GROUP)
    w = jax.nn.softmax(top_v, axis=-1) * g_p
    ids = g_sel[:, None] * EXPERTS_PER_GROUP + top_i
    gates = jnp.sum(jax.nn.one_hot(ids, N_EXPERTS, dtype=jnp.float32) * w[..., None], axis=1)
    a = jnp.einsum('td,edf->tef', t, w_gate)
    u = jnp.einsum('td,edf->tef', t, w_up)
    hid = jax.nn.silu(a) * u * gates[..., None].astype(t.dtype)
    y = jnp.einsum('tef,efd->td', hid, w_down)
    return y.reshape(B_, S_, D)


def setup_inputs(seed: int = 0) -> dict:
    key = jax.random.key(seed)
    ks = jax.random.split(key, 27)
    n = lambda k, s: jax.random.normal(k, s, dtype=jnp.float32)
    L, D = DEPTH, D_MODEL
    return {
        "x": n(ks[0], (BATCH, SEQ, D)),
        "p": n(ks[1], (L, BATCH, SEQ, PLE_DIM)),
        "rel_table": 0.3 * n(ks[2], (REL_BUCKETS, REL_HEADS)),
        "w_in": n(ks[3], (L, D, IN_W)) * D ** -0.5,
        "b_f": 0.1 * n(ks[4], (L, FOX_HEADS)),
        "lam_q1": 0.1 * n(ks[5], (L, HEAD_DIM)),
        "lam_k1": 0.1 * n(ks[6], (L, HEAD_DIM)),
        "lam_q2": 0.1 * n(ks[7], (L, HEAD_DIM)),
        "lam_k2": 0.1 * n(ks[8], (L, HEAD_DIM)),
        "diff_norm_g": 1.0 + 0.02 * n(ks[9], (L, 2 * HEAD_DIM)),
        "pool_w": n(ks[10], (L, POOL_GROUPS, POOL_CH, POOL_CH)) * POOL_CH ** -0.5,
        "pool_scale": 1.0 + 0.02 * n(ks[11], (L, GROUP_W)),
        "sinks": 0.5 * n(ks[12], (L, SWA_HEADS)),
        "w_o": n(ks[13], (L, MIX_W, D)) * MIX_W ** -0.5 * BETA,
        "ln1_g": 1.0 + 0.02 * n(ks[14], (L, D)),
        "ln1_b": 0.02 * n(ks[15], (L, D)),
        "router_g_w": n(ks[16], (L, D, MOE_GROUPS)) * D ** -0.5,
        "router_g_b": 0.01 * n(ks[17], (L, MOE_GROUPS)),
        "router_e_w": n(ks[18], (L, D, N_EXPERTS)) * D ** -0.5,
        "router_e_b": 0.01 * n(ks[19], (L, N_EXPERTS)),
        "w_gate": n(ks[20], (L, N_EXPERTS, D, D_EXPERT)) * D ** -0.5,
        "w_up": n(ks[21], (L, N_EXPERTS, D, D_EXPERT)) * D ** -0.5,
        "w_down": n(ks[22], (L, N_EXPERTS, D_EXPERT, D)) * D_EXPERT ** -0.5 * BETA,
        "ple_gate_w": n(ks[23], (L, D, D)) * D ** -0.5,
        "ple_up_w": n(ks[24], (L, PLE_DIM, D)) * PLE_DIM ** -0.5 * BETA,
        "ln2_g": 1.0 + 0.02 * n(ks[25], (L, D)),
        "ln2_b": 0.02 * n(ks[26], (L, D)),
    }


def reference(x, p, rel_table, w_in, b_f, lam_q1, lam_k1, lam_q2, lam_k2, diff_norm_g,
              pool_w, pool_scale, sinks, w_o, ln1_g, ln1_b, router_g_w, router_g_b,
              router_e_w, router_e_b, w_gate, w_up, w_down, ple_gate_w, ple_up_w,
              ln2_g, ln2_b):
    B_, S_, _ = x.shape
    bias_by_dist = rel_table[_t5_bucket(jnp.arange(S_, dtype=jnp.int32))]
    diff_bias = bias_by_dist[:, :DIFF_HEADS]
    swa_bias = bias_by_dist[:SWA_WINDOW, DIFF_HEADS:]
    for i in range(DEPTH):
        proj = x @ w_in[i]
        fq, fk, fv, ff, dq, dk, dv, pu, sq, sk, sv = _split_cols(proj)
        y_fox = _forgetting_attention(
            fq.reshape(B_, S_, FOX_HEADS, HEAD_DIM), fk.reshape(B_, S_, FOX_HEADS, HEAD_DIM),
            fv.reshape(B_, S_, FOX_HEADS, HEAD_DIM), ff + b_f[i]).reshape(B_, S_, GROUP_W)
        lam_init = 0.8 - 0.6 * math.exp(-0.3 * i)
        lam = (jnp.exp(jnp.sum(lam_q1[i].astype(jnp.float32) * lam_k1[i].astype(jnp.float32)))
               - jnp.exp(jnp.sum(lam_q2[i].astype(jnp.float32) * lam_k2[i].astype(jnp.float32)))
               + lam_init)
        y_diff = _diff_attention(
            dq.reshape(B_, S_, DIFF_HEADS, 2, HEAD_DIM), dk.reshape(B_, S_, DIFF_HEADS, 2, HEAD_DIM),
            dv.reshape(B_, S_, DIFF_HEADS, 2 * HEAD_DIM), diff_bias, lam, lam_init, diff_norm_g[i])
        y_pool = _pool_mixer(pu, pool_w[i], pool_scale[i])
        y_swa = _sliding_window_attention(
            sq.reshape(B_, S_, SWA_HEADS, HEAD_DIM), sk.reshape(B_, S_, SWA_KV_HEADS, HEAD_DIM),
            sv.reshape(B_, S_, SWA_KV_HEADS, HEAD_DIM), swa_bias, sinks[i])
        mix = jnp.concatenate([y_fox, y_diff, y_pool, y_swa], axis=-1)
        h = _layer_norm(ALPHA * x + mix @ w_o[i], ln1_g[i], ln1_b[i])
        y_moe = _hier_moe(h, router_g_w[i], router_g_b[i], router_e_w[i], router_e_b[i],
                          w_gate[i], w_up[i], w_down[i])
        ple = jax.nn.sigmoid(h @ ple_gate_w[i]) * (p[i] @ ple_up_w[i])
        x = _layer_norm(ALPHA * h + y_moe + ple, ln2_g[i], ln2_b[i])
    return x
```

```cpp
#include <hip/hip_runtime.h>
#include <cstdio>
#include <cstdint>
#include <cmath>
namespace pg8 {
#define PG8_LAS __attribute__((address_space(3)))
typedef unsigned short bf16_t;
typedef short bf16x8 __attribute__((ext_vector_type(8)));
typedef float f32x4 __attribute__((ext_vector_type(4)));
typedef unsigned u32x4 __attribute__((ext_vector_type(4)));
constexpr int BM = 256, BK = 64, HALF = 128, HTB = HALF * BK * 2  , STAGE_BYTES = 8 * HTB, NXCD = 8, WGM = 8;

__host__ __device__ __forceinline__ int lds_byte(int r, int c) { const int st = (r >> 4) * 2 + (c >> 5), rr = r & 15, cc = c & 31, ob = rr * 64 + cc * 2; return st * 1024 + (ob ^ (((ob >> 9) & 1) << 5)); }
__host__ __device__ __forceinline__ void stage_rc(int b, int& R, int& C) { const int st = b / 1024, sb = b % 1024, swz = sb ^ (((sb >> 9) & 1) << 5); R = (st >> 1) * 16 + swz / 64; C = (st & 1) * 32 + (swz % 64) / 2; }
__host__ __device__ __forceinline__ int perm32(int rho) { const int n = rho >> 4, i = rho & 15; return 8 * (i >> 2) + 4 * n + (i & 3); }

struct Unit { int pm, pn; };
struct Gemm { const bf16_t* A; const bf16_t* Bt; int M, N, K; };

struct StaticOrder {
    int nM, nN, nwg, G, c;
    __host__ __device__ void init(int M, int N, int G_, int c_) { nM = M / BM; nN = N / BM; nwg = nM * nN; G = G_; c = c_; }
    __host__ __device__ bool next(int i, Unit& u) const {
        const long L = (long)i * G + c; if (L >= nwg) return false;
        int wgid = (int)L; { const int q = nwg / NXCD, r = nwg % NXCD, xcd = wgid % NXCD, off = wgid / NXCD; wgid = (xcd < r ? xcd * (q + 1) : r * (q + 1) + (xcd - r) * q) + off; }
        const int nig = WGM * nN, gid = wgid / nig, fm = gid * WGM, gsz = (nM - fm) < WGM ? (nM - fm) : WGM;
        u.pm = fm + ((wgid % nig) % gsz); u.pn = (wgid % nig) / gsz; return true;
    }
    __device__ __forceinline__ void a_ready(const Unit&) const {}
    __device__ __forceinline__ void done(const Unit&) const {}
};

__device__ __forceinline__ unsigned cvt_pk_bf16(float lo, float hi) { unsigned r; asm volatile("v_cvt_pk_bf16_f32 %0, %1, %2" : "=v"(r) : "v"(lo), "v"(hi)); return r; }
typedef float f32x2 __attribute__((ext_vector_type(2)));
__device__ __forceinline__ f32x2 gelu_pk(f32x2 v) {
    const f32x2 av = __builtin_elementwise_abs(v), d = av * 0.2316418882f + 1.0f;
    f32x2 t; t.x = __builtin_amdgcn_rcpf(d.x); t.y = __builtin_amdgcn_rcpf(d.y);
    f32x2 q = t * 0.5307027145f + (-0.7265760135f); q = q * t + 0.7107068705f; q = q * t + (-0.142248368f); q = q * t + 0.127414796f; q = q * t;
    const f32x2 s = (v * v) * (-0.72134752044f);
    f32x2 e; e.x = __builtin_amdgcn_exp2f(s.x); e.y = __builtin_amdgcn_exp2f(s.y);
    const f32x2 m = v * (q * e), r = v - m;
    f32x2 o; o.x = v.x < 0.f ? m.x : r.x; o.y = v.y < 0.f ? m.y : r.y; return o;
}

template <int ACT  > struct EpiBf16 {
    static constexpr bool PERM = true, AFTER_DRAIN = false; static_assert(ACT == 0 || ACT == 1, "EpiBf16: ACT is 0 (none) or 1 (gelu_pk)");
    bf16_t* O; int ldc; const float* bias; int split_cols; size_t split_stride; float scale0;
    __device__ __forceinline__ void operator()(const f32x4 (&acc)[2][2][4][2], const Unit& u, int wr, int wc, int fr, int fq) const {
        const int row0 = u.pm * BM + wr * 64 + fr; int colt = u.pn * BM; bf16_t* base = O;
        float sc = 1.f; if (split_cols) { const int t = colt / split_cols; base += (size_t)t * split_stride; colt -= t * split_cols; if (t == 0) sc = scale0; }
        const int col0 = colt + wc * 32 + 8 * fq, bcol0 = u.pn * BM + wc * 32 + 8 * fq;
        f32x4 bv[2][2];
#pragma unroll
        for (int bj = 0; bj < 2; ++bj)
#pragma unroll
            for (int n = 0; n < 2; ++n) bv[bj][n] = bias ? *(const f32x4*)(bias + bcol0 + bj * HALF + 4 * n) : (f32x4){0.f, 0.f, 0.f, 0.f};
#pragma unroll
        for (int ai = 0; ai < 2; ++ai)
#pragma unroll
            for (int m = 0; m < 4; ++m) { bf16_t* rowp = base + (size_t)(row0 + ai * HALF + m * 16) * ldc + col0;
#pragma unroll
                for (int bj = 0; bj < 2; ++bj) { f32x4 v0 = acc[ai][bj][m][0] + bv[bj][0], v1 = acc[ai][bj][m][1] + bv[bj][1];
                    if (ACT == 1) { f32x2 a = gelu_pk((f32x2){v0[0], v0[1]}), b = gelu_pk((f32x2){v0[2], v0[3]}), c = gelu_pk((f32x2){v1[0], v1[1]}), d = gelu_pk((f32x2){v1[2], v1[3]});
                        v0 = (f32x4){a.x, a.y, b.x, b.y}; v1 = (f32x4){c.x, c.y, d.x, d.y}; }
                    v0 = v0 * sc; v1 = v1 * sc; u32x4 w; w.x = cvt_pk_bf16(v0[0], v0[1]); w.y = cvt_pk_bf16(v0[2], v0[3]); w.z = cvt_pk_bf16(v1[0], v1[1]); w.w = cvt_pk_bf16(v1[2], v1[3]);
                    *(u32x4*)(rowp + bj * HALF) = w; } }
    }
};

struct PanelStats {
    unsigned* xbuf;
    unsigned* cnt;
    unsigned* tmo;
    int ntn; float eps;
    unsigned code;
    __device__ __forceinline__ bool run(const f32x4 (&v)[2][2][4][2], const Unit& u, int wr, int wc, int fr, int fq, PG8_LAS unsigned char* lds, int wid, int lane) const {
        typedef float f32x2v __attribute__((ext_vector_type(2)));
        PG8_LAS f32x2v* P = (PG8_LAS f32x2v*)lds;
        PG8_LAS f32x2v* S = (PG8_LAS f32x2v*)(lds + 8192);
        PG8_LAS unsigned* flag = (PG8_LAS unsigned*)(lds + 8192 + 2048);
#pragma unroll
        for (int ai = 0; ai < 2; ++ai)
#pragma unroll
            for (int m = 0; m < 4; ++m) {
                float s = 0.f;
#pragma unroll
                for (int bj = 0; bj < 2; ++bj)
#pragma unroll
                    for (int n = 0; n < 2; ++n) { const f32x4 x = v[ai][bj][m][n]; s += (x[0] + x[1]) + (x[2] + x[3]); }
                s += __shfl_xor(s, 16); s += __shfl_xor(s, 32);
                const float mw = s * (1.0f / 64.0f); float q = 0.f;
#pragma unroll
                for (int bj = 0; bj < 2; ++bj)
#pragma unroll
                    for (int n = 0; n < 2; ++n) { const f32x4 d = v[ai][bj][m][n] - mw; q += (d[0] * d[0] + d[1] * d[1]) + (d[2] * d[2] + d[3] * d[3]); }
                q += __shfl_xor(q, 16); q += __shfl_xor(q, 32);
                if (fq == 0) P[(ai * HALF + wr * 64 + m * 16 + fr) * 4 + wc] = (f32x2v){mw, q};
            }
        asm volatile("s_waitcnt lgkmcnt(0)" ::: "memory"); __builtin_amdgcn_s_barrier(); asm volatile("" ::: "memory");
#if defined(BROKEN_EXCHANGE_NO_WAIT)
#warning BROKEN CONTROL BUILD: the row-statistics exchange does not wait; results are wrong by design
        if (blockIdx.x >= 64) { const long long t0_ = clock64(); while (clock64() - t0_ < 60000) __builtin_amdgcn_s_sleep(8); }
#endif
        const int row = wid * 32 + (lane & 31);
        if (lane < 32) {
            const f32x2v a = P[row * 4 + 0], b = P[row * 4 + 1], c = P[row * 4 + 2], d = P[row * 4 + 3];
            const float mt = (a.x + b.x + c.x + d.x) * 0.25f;
            const float da = a.x - mt, db = b.x - mt, dc = c.x - mt, dd = d.x - mt;
            const float m2 = (a.y + b.y) + (c.y + d.y) + 64.0f * ((da * da + db * db) + (dc * dc + dd * dd));
            unsigned long long* slot = (unsigned long long*)xbuf + ((size_t)(u.pm * BM + row) * 4 + u.pn);
            __hip_atomic_store(slot, ((unsigned long long)__float_as_uint(m2) << 32) | __float_as_uint(mt), __ATOMIC_RELAXED, __HIP_MEMORY_SCOPE_AGENT);
        }
        asm volatile("s_waitcnt vmcnt(0)" ::: "memory");
        if (lane == 0) __hip_atomic_fetch_add(cnt + 64 * u.pm, 1u, __ATOMIC_RELAXED, __HIP_MEMORY_SCOPE_AGENT);
        if (wid == 0) {
            bool dead = false; const unsigned long long t0 = __builtin_amdgcn_s_memrealtime(); const unsigned want = 8u * (unsigned)ntn;
            for (;;) {
#if defined(BROKEN_EXCHANGE_NO_WAIT)
                break;
#endif
                if ((unsigned)__builtin_amdgcn_readfirstlane(__hip_atomic_load(cnt + 64 * u.pm, __ATOMIC_RELAXED, __HIP_MEMORY_SCOPE_AGENT)) >= want) break;
                if (__builtin_amdgcn_s_memrealtime() - t0 > 2000000ull) {
                    if (lane == 0) { unsigned expect = 0u; __hip_atomic_compare_exchange_strong(tmo + 1, &expect, code | (unsigned)(u.pm & 0xff), __ATOMIC_RELAXED, __ATOMIC_RELAXED, __HIP_MEMORY_SCOPE_AGENT);
                                     __hip_atomic_store(tmo, 1u, __ATOMIC_RELAXED, __HIP_MEMORY_SCOPE_AGENT); }
                    dead = true; break; }
                __builtin_amdgcn_s_sleep(2);
            }
            __builtin_amdgcn_fence(__ATOMIC_ACQUIRE, "agent");
            if (lane == 0) flag[0] = dead ? 1u : 0u;
        }
        asm volatile("s_waitcnt vmcnt(0) lgkmcnt(0)" ::: "memory"); __builtin_amdgcn_s_barrier(); asm volatile("" ::: "memory");
        const bool bad = flag[0] != 0u;
        if (lane < 32) {
            const unsigned long long* slot = (const unsigned long long*)xbuf + (size_t)(u.pm * BM + row) * 4; float mt[4], m2[4]; float ms = 0.f;
#pragma unroll
            for (int t = 0; t < 4; ++t) { if (t < ntn) { const unsigned long long w = __hip_atomic_load(slot + t, __ATOMIC_RELAXED, __HIP_MEMORY_SCOPE_AGENT); mt[t] = __uint_as_float((unsigned)w); m2[t] = __uint_as_float((unsigned)(w >> 32)); } else { mt[t] = 0.f; m2[t] = 0.f; } ms += mt[t]; }
            const float mean = ms / (float)ntn; float q = 0.f;
#pragma unroll
            for (int t = 0; t < 4; ++t) if (t < ntn) { const float dm = mt[t] - mean; q += m2[t] + 256.0f * dm * dm; }
            S[row] = (f32x2v){mean, 1.0f / sqrtf(q / (256.0f * (float)ntn) + eps)};
        }
        asm volatile("s_waitcnt lgkmcnt(0)" ::: "memory"); __builtin_amdgcn_s_barrier(); asm volatile("" ::: "memory");
        return bad;
    }
};
struct EpiLnRes {
    static constexpr bool PERM = false, AFTER_DRAIN = true;
    const float* base; float* out; int ldc; const float* bias; PanelStats st; unsigned poison;
    __device__ __forceinline__ void fused(f32x4 (&acc)[2][2][4][2], const Unit& u, int wr, int wc, int fr, int fq, PG8_LAS unsigned char* lds, int wid, int lane) const {
        typedef float f32x2v __attribute__((ext_vector_type(2)));
        const PG8_LAS f32x2v* S = (const PG8_LAS f32x2v*)(lds + 8192);
        const int col0 = u.pn * BM + wc * 32 + 4 * fq;
#pragma unroll
        for (int bj = 0; bj < 2; ++bj)
#pragma unroll
            for (int n = 0; n < 2; ++n) { const f32x4 bv = bias ? *(const f32x4*)(bias + col0 + bj * HALF + n * 16) : (f32x4){0.f, 0.f, 0.f, 0.f};
#pragma unroll
                for (int ai = 0; ai < 2; ++ai)
#pragma unroll
                    for (int m = 0; m < 4; ++m) acc[ai][bj][m][n] += bv; }
        f32x4 pre[4][2][2];
#pragma unroll
        for (int m = 0; m < 4; ++m) { const size_t off = (size_t)(u.pm * BM + wr * 64 + m * 16 + fr) * ldc + col0;
#pragma unroll
            for (int bj = 0; bj < 2; ++bj)
#pragma unroll
                for (int n = 0; n < 2; ++n) pre[m][bj][n] = *(const f32x4*)(base + off + bj * HALF + n * 16); }
        const bool bad = st.run(acc, u, wr, wc, fr, fq, lds, wid, lane) || poison != 0u;
        const float qnan = __builtin_nanf("");
#pragma unroll
        for (int ai = 0; ai < 2; ++ai)
#pragma unroll
            for (int m = 0; m < 4; ++m) { const int r = ai * HALF + wr * 64 + m * 16 + fr; const f32x2v sr = S[r]; const size_t off = (size_t)(u.pm * BM + r) * ldc + col0;
#pragma unroll
                for (int bj = 0; bj < 2; ++bj)
#pragma unroll
                    for (int n = 0; n < 2; ++n) { const f32x4 bs = ai == 0 ? pre[m][bj][n] : *(const f32x4*)(base + off + bj * HALF + n * 16); f32x4 o = bs + (acc[ai][bj][m][n] - sr.x) * sr.y;
                        if (bad) o = (f32x4){qnan, qnan, qnan, qnan}; *(f32x4*)(out + off + bj * HALF + n * 16) = o; }
                if (m & 1) asm volatile("" ::: "memory"); }
    }
};
struct EpiLnResLn {
    static constexpr bool PERM = false, AFTER_DRAIN = true;
    const float* base; float* out; bf16_t* xn; int ldc; const float* bias; PanelStats st1, st2; unsigned poison;
    __device__ __forceinline__ void fused(f32x4 (&acc)[2][2][4][2], const Unit& u, int wr, int wc, int fr, int fq, PG8_LAS unsigned char* lds, int wid, int lane) const {
        typedef float f32x2v __attribute__((ext_vector_type(2))); typedef unsigned u32x2v __attribute__((ext_vector_type(2)));
        const PG8_LAS f32x2v* S = (const PG8_LAS f32x2v*)(lds + 8192);
        const int col0 = u.pn * BM + wc * 32 + 4 * fq;
#pragma unroll
        for (int bj = 0; bj < 2; ++bj)
#pragma unroll
            for (int n = 0; n < 2; ++n) { const f32x4 bv = bias ? *(const f32x4*)(bias + col0 + bj * HALF + n * 16) : (f32x4){0.f, 0.f, 0.f, 0.f};
#pragma unroll
                for (int ai = 0; ai < 2; ++ai)
#pragma unroll
                    for (int m = 0; m < 4; ++m) acc[ai][bj][m][n] += bv; }
        bool bad = st1.run(acc, u, wr, wc, fr, fq, lds, wid, lane) || poison != 0u;
        const float qnan = __builtin_nanf("");
#pragma unroll
        for (int ai = 0; ai < 2; ++ai)
#pragma unroll
            for (int m = 0; m < 4; ++m) { const int r = ai * HALF + wr * 64 + m * 16 + fr; const f32x2v sr = S[r]; const size_t off = (size_t)(u.pm * BM + r) * ldc + col0;
#pragma unroll
                for (int bj = 0; bj < 2; ++bj)
#pragma unroll
                    for (int n = 0; n < 2; ++n) { const f32x4 bs = *(const f32x4*)(base + off + bj * HALF + n * 16); acc[ai][bj][m][n] = bs + (acc[ai][bj][m][n] - sr.x) * sr.y; }
                asm volatile("" : "+v"(acc[ai][0][m][0]), "+v"(acc[ai][0][m][1]), "+v"(acc[ai][1][m][0]), "+v"(acc[ai][1][m][1]));
                if (m & 1) asm volatile("" ::: "memory"); }
        const bool bad1 = bad;
        bad = st2.run(acc, u, wr, wc, fr, fq, lds, wid, lane) || bad;
#pragma unroll
        for (int ai = 0; ai < 2; ++ai)
#pragma unroll
            for (int m = 0; m < 4; ++m) { const int r = ai * HALF + wr * 64 + m * 16 + fr; const f32x2v sr = S[r]; const size_t off = (size_t)(u.pm * BM + r) * ldc + col0;
#pragma unroll
                for (int bj = 0; bj < 2; ++bj)
#pragma unroll
                    for (int n = 0; n < 2; ++n) { const f32x4 x1 = acc[ai][bj][m][n]; *(f32x4*)(out + off + bj * HALF + n * 16) = bad1 ? (f32x4){qnan, qnan, qnan, qnan} : x1;
                        const f32x4 o = (x1 - sr.x) * sr.y; u32x2v w; w.x = cvt_pk_bf16(o[0], o[1]); w.y = cvt_pk_bf16(o[2], o[3]);
                        if (bad) { w.x = 0x7fc07fc0u; w.y = 0x7fc07fc0u; } *(u32x2v*)(xn + off + bj * HALF + n * 16) = w; }
                asm volatile("" ::: "memory"); }
    }
};

template <class Epi, class Sched, bool ALIGN_EPI = false, bool SP2 = false>
__device__ __forceinline__ void gemm_phase(PG8_LAS unsigned char* lds, const Gemm g, const Sched& S, const Epi& E) {
    const int tid = threadIdx.x, wid = __builtin_amdgcn_readfirstlane(tid >> 6), lane = tid & 63, wr = wid >> 2, wc = wid & 3, fr = lane & 15, fq = lane >> 4;
    const int K = g.K, nt = K / BK;
    unsigned voffA[2], voffB[2];
#pragma unroll
    for (int i = 0; i < 2; ++i) { int R, C; stage_rc(tid * 16 + i * 8192, R, C); const int Rb = Epi::PERM ? ((R & ~31) + perm32(R & 31)) : R;
        voffA[i] = (unsigned)(R * K + C) * 2u; voffB[i] = (unsigned)(Rb * K + C) * 2u; }
    const size_t kstep = (size_t)(BK * 2);
    const size_t hstep = (size_t)HALF * K * 2;
    const size_t tstep = 2 * hstep;
    const unsigned ldsw = (unsigned)wid * 1024u;
    const int aoff = lds_byte(wr * 64 + fr, fq * 8), boff = lds_byte(wc * 32 + fr, fq * 8);
#define PG8_SA(b, h) (((b) * 2 + (h)) * HTB)
#define PG8_SB(b, h) ((4 + (b) * 2 + (h)) * HTB)
#define PG8_STAGE(bufoff, gbase, voff) do { _Pragma("unroll") for (int _i = 0; _i < 2; ++_i) \
        __builtin_amdgcn_global_load_lds((const unsigned*)((const char*)(gbase) + (voff)[_i]), (PG8_LAS unsigned*)(lds + (bufoff) + ldsw + _i * 8192), 16, 0, 0); } while (0)
#define PG8_LDA(dst, b, h) do { _Pragma("unroll") for (int m = 0; m < 4; ++m) _Pragma("unroll") for (int k = 0; k < 2; ++k) dst[m][k] = *(const PG8_LAS bf16x8*)(lds + PG8_SA(b, h) + aoff + m * 2048 + k * 1024); } while (0)
#define PG8_LDB(dst, b, h) do { _Pragma("unroll") for (int n = 0; n < 2; ++n) _Pragma("unroll") for (int k = 0; k < 2; ++k) dst[n][k] = *(const PG8_LAS bf16x8*)(lds + PG8_SB(b, h) + boff + n * 2048 + k * 1024); } while (0)
#define PG8_MMA(ai, bj, At, Bt) do { __builtin_amdgcn_s_setprio(1); _Pragma("unroll") for (int m = 0; m < 4; ++m) _Pragma("unroll") for (int n = 0; n < 2; ++n) _Pragma("unroll") for (int k = 0; k < 2; ++k) \
        acc[ai][bj][m][n] = __builtin_amdgcn_mfma_f32_16x16x32_bf16(Bt[n][k], At[m][k], acc[ai][bj][m][n], 0, 0, 0); __builtin_amdgcn_s_setprio(0); } while (0)
#define PG8_WAIT_V(n) asm volatile("s_waitcnt vmcnt(" #n ")" ::: "memory")
#define PG8_WAIT_L(n) asm volatile("s_waitcnt lgkmcnt(" #n ")" ::: "memory")
#define PG8_BAR __builtin_amdgcn_s_barrier()
#define PG8_SCHED __builtin_amdgcn_sched_barrier(0)
    Unit cur, nxt; int ui = 0;
    if (!S.next(0, cur)) return;
    f32x4 acc[2][2][4][2];
#pragma unroll
    for (int a = 0; a < 2; ++a)
#pragma unroll
        for (int b = 0; b < 2; ++b)
#pragma unroll
            for (int m = 0; m < 4; ++m)
#pragma unroll
                for (int n = 0; n < 2; ++n) acc[a][b][m][n] = (f32x4){0.f, 0.f, 0.f, 0.f};
    bf16x8 At[4][2], B0[2][2], B1[2][2];
    const char* cA = (const char*)g.A + (size_t)cur.pm * tstep; const char* cB = (const char*)g.Bt + (size_t)cur.pn * tstep;
    S.a_ready(cur);
    if constexpr (SP2) {
        PG8_STAGE(PG8_SB(0, 0), cB, voffB); PG8_STAGE(PG8_SB(0, 1), cB + hstep, voffB); PG8_STAGE(PG8_SA(0, 0), cA, voffA); PG8_STAGE(PG8_SA(0, 1), cA + hstep, voffA);
        if (wr == 1) PG8_BAR;
        PG8_WAIT_V(2); PG8_BAR;
        PG8_STAGE(PG8_SB(1, 0), cB + kstep, voffB); PG8_STAGE(PG8_SA(1, 0), cA + kstep, voffA); PG8_STAGE(PG8_SB(1, 1), cB + hstep + kstep, voffB);
        PG8_WAIT_V(6); PG8_BAR;
    } else {
        PG8_STAGE(PG8_SB(0, 0), cB, voffB); PG8_STAGE(PG8_SA(0, 0), cA, voffA); PG8_STAGE(PG8_SB(0, 1), cB + hstep, voffB); PG8_STAGE(PG8_SA(0, 1), cA + hstep, voffA);
        if (wr == 1) PG8_BAR;
        PG8_WAIT_V(4); PG8_BAR;
        PG8_STAGE(PG8_SB(1, 0), cB + kstep, voffB); PG8_STAGE(PG8_SA(1, 0), cA + kstep, voffA); PG8_STAGE(PG8_SB(1, 1), cB + hstep + kstep, voffB);
        PG8_WAIT_V(6); PG8_BAR;
    }
    for (;;) {
        const bool has_next = S.next(ui + 1, nxt);
        const char* nA = has_next ? (const char*)g.A + (size_t)nxt.pm * tstep : cA; const char* nB = has_next ? (const char*)g.Bt + (size_t)nxt.pn * tstep : cB;
        for (int t = 0; t < nt; t += 2) {
            const bool last = (t == nt - 2);
            const char* a1 = cA + (size_t)(t + 1) * kstep;
            const char* a2 = last ? nA : cA + (size_t)(t + 2) * kstep; const char* b2 = last ? nB : cB + (size_t)(t + 2) * kstep;
            const char* a3 = a2 + kstep; const char* b3 = b2 + kstep;
            if (last && has_next) S.a_ready(nxt);
            if constexpr (SP2) {
            PG8_LDB(B0, 0, 0); PG8_LDB(B1, 0, 1); PG8_SCHED; PG8_LDA(At, 0, 0); PG8_STAGE(PG8_SA(1, 1), a1 + hstep, voffA);
            PG8_WAIT_V(8); PG8_WAIT_L(0); PG8_BAR; PG8_MMA(0, 0, At, B0); PG8_MMA(0, 1, At, B1); PG8_BAR; PG8_SCHED;
            PG8_LDA(At, 0, 1); PG8_STAGE(PG8_SB(0, 0), b2, voffB); PG8_STAGE(PG8_SB(0, 1), b2 + hstep, voffB); PG8_STAGE(PG8_SA(0, 0), a2, voffA);
            PG8_WAIT_V(8); PG8_WAIT_L(0); PG8_BAR; PG8_MMA(1, 0, At, B0); PG8_MMA(1, 1, At, B1); PG8_BAR; PG8_SCHED;
            PG8_LDB(B0, 1, 0); PG8_LDB(B1, 1, 1); PG8_SCHED; PG8_LDA(At, 1, 0); PG8_STAGE(PG8_SA(0, 1), a2 + hstep, voffA);
            PG8_WAIT_V(8); PG8_WAIT_L(0); PG8_BAR; PG8_MMA(0, 0, At, B0); PG8_MMA(0, 1, At, B1); PG8_BAR; PG8_SCHED;
            PG8_LDA(At, 1, 1); PG8_STAGE(PG8_SB(1, 0), b3, voffB); PG8_STAGE(PG8_SB(1, 1), b3 + hstep, voffB); PG8_STAGE(PG8_SA(1, 0), a3, voffA);
            PG8_WAIT_V(8); PG8_WAIT_L(0); PG8_BAR; PG8_MMA(1, 0, At, B0); PG8_MMA(1, 1, At, B1); PG8_BAR; PG8_SCHED;
            } else {
            PG8_LDB(B0, 0, 0); PG8_SCHED; PG8_LDA(At, 0, 0); PG8_STAGE(PG8_SA(1, 1), a1 + hstep, voffA);
            PG8_WAIT_L(8); PG8_BAR; PG8_WAIT_L(0); PG8_MMA(0, 0, At, B0); PG8_BAR; PG8_SCHED;
            PG8_LDB(B1, 0, 1); PG8_STAGE(PG8_SB(0, 0), b2, voffB);
            PG8_BAR; PG8_WAIT_L(0); PG8_MMA(0, 1, At, B1); PG8_BAR;
            PG8_LDA(At, 0, 1); PG8_STAGE(PG8_SA(0, 0), a2, voffA);
            PG8_BAR; PG8_WAIT_L(0); PG8_MMA(1, 0, At, B0); PG8_BAR; PG8_SCHED;
            PG8_STAGE(PG8_SB(0, 1), b2 + hstep, voffB);
            PG8_WAIT_V(6); PG8_BAR; PG8_MMA(1, 1, At, B1); PG8_BAR;
            PG8_LDB(B0, 1, 0); PG8_SCHED; PG8_LDA(At, 1, 0); PG8_STAGE(PG8_SA(0, 1), a2 + hstep, voffA);
            PG8_WAIT_L(8); PG8_BAR; PG8_WAIT_L(0); PG8_MMA(0, 0, At, B0); PG8_BAR; PG8_SCHED;
            PG8_LDB(B1, 1, 1); PG8_STAGE(PG8_SB(1, 0), b3, voffB);
            PG8_BAR; PG8_WAIT_L(0); PG8_MMA(0, 1, At, B1); PG8_BAR;
            PG8_LDA(At, 1, 1); PG8_STAGE(PG8_SA(1, 0), a3, voffA);
            PG8_BAR; PG8_WAIT_L(0); PG8_MMA(1, 0, At, B0); PG8_BAR; PG8_SCHED;
            PG8_STAGE(PG8_SB(1, 1), b3 + hstep, voffB);
            PG8_WAIT_V(6); PG8_BAR; PG8_MMA(1, 1, At, B1); PG8_BAR;
            }
        }
        if constexpr (ALIGN_EPI) { if (wr == 0) PG8_BAR; }
        if constexpr (!Epi::AFTER_DRAIN) { E(acc, cur, wr, wc, fr, fq); S.done(cur); }
        if (!has_next) break;
#pragma unroll
        for (int a = 0; a < 2; ++a)
#pragma unroll
            for (int b = 0; b < 2; ++b)
#pragma unroll
                for (int m = 0; m < 4; ++m)
#pragma unroll
                    for (int n = 0; n < 2; ++n) acc[a][b][m][n] = (f32x4){0.f, 0.f, 0.f, 0.f};
        cur = nxt; cA = nA; cB = nB; ++ui;
        if constexpr (ALIGN_EPI) { if (wr == 1) PG8_BAR; }
    }
    PG8_WAIT_V(0);
    if constexpr (!ALIGN_EPI) { if (wr == 0) PG8_BAR; }
    PG8_BAR;
    if constexpr (Epi::AFTER_DRAIN) { E.fused(acc, cur, wr, wc, fr, fq, lds, wid, lane); S.done(cur); }
#undef PG8_SA
#undef PG8_SB
#undef PG8_STAGE
#undef PG8_LDA
#undef PG8_LDB
#undef PG8_MMA
#undef PG8_WAIT_V
#undef PG8_WAIT_L
#undef PG8_BAR
#undef PG8_SCHED
}
}
#define GAS __attribute__((address_space(1)))
#define LAS __attribute__((address_space(3)))
typedef unsigned short bf16;
typedef unsigned v4u __attribute__((ext_vector_type(4)));
typedef float f32x4 __attribute__((ext_vector_type(4)));
typedef short bf16x8 __attribute__((ext_vector_type(8)));
typedef GAS unsigned gu32;
typedef GAS unsigned long long gu64;
#define RLX_AGENT __ATOMIC_RELAXED, __HIP_MEMORY_SCOPE_AGENT
#define LDS_WAIT() asm volatile("s_waitcnt lgkmcnt(0)" ::: "memory")
#define VM_WAIT() asm volatile("s_waitcnt vmcnt(0)" ::: "memory")
__device__ __forceinline__ unsigned long long rt() { return __builtin_amdgcn_s_memrealtime(); }
__device__ __forceinline__ unsigned f2bf(float f) { unsigned u = __builtin_bit_cast(unsigned, f); return (u + 0x7fffu + ((u >> 16) & 1u)) >> 16; }
__device__ __forceinline__ unsigned pk2(float lo, float hi) { return f2bf(lo) | (f2bf(hi) << 16); }

#define XB_TMO      128
#define XB_XCNT(j)  (256  + 64 * (j))
#define XB_XSUB(j)  (1280 + 64 * (j))
#define XB_XGEN(j)  (2304 + 64 * (j))
#define XB_TOP      3328
#define XB_TOPGEN   3392
#define XCD_BAR_WORDS 3456
#define XB_SPIN_CAP (1u << 18)

__device__ __forceinline__ unsigned xb_ld(unsigned* p)              { return __hip_atomic_load(p, __ATOMIC_RELAXED, __HIP_MEMORY_SCOPE_AGENT); }
__device__ __forceinline__ unsigned xb_add(unsigned* p, unsigned v) { return __hip_atomic_fetch_add(p, v, __ATOMIC_RELAXED, __HIP_MEMORY_SCOPE_AGENT); }
__device__ __forceinline__ unsigned xb_xcc_id() { return (unsigned)__builtin_amdgcn_s_getreg((3 << 11) | 20) & 0xFu; }
#define XB_SPIN(cond, bar) do { unsigned _sp = 0; while (cond) { __builtin_amdgcn_s_sleep(1); \
    if ((++_sp & 255u) == 0u) { if (xb_ld(&(bar)[XB_TMO])) break; if (_sp > XB_SPIN_CAP) { atomicAdd(&(bar)[XB_TMO], 1u); break; } } } } while (0)

struct XcdBarrier {
    unsigned* bar; unsigned x;
    volatile LAS unsigned* st;
};

__device__ __forceinline__ XcdBarrier xcd_barrier_post(unsigned* bar, volatile LAS unsigned* st) {
    XcdBarrier b; b.bar = bar; b.x = xb_xcc_id(); b.st = st;
    if (threadIdx.x == 0) (void)xb_add(&bar[XB_XCNT(b.x)], 1u);
    return b;
}
__device__ __forceinline__ void xcd_barrier_complete(unsigned* bar, unsigned x, unsigned& nloc, unsigned& nx) {
    const unsigned G = gridDim.x * gridDim.y * gridDim.z;
    unsigned sum, cnt, mine, sp = 0u;
    for (;;) {
        sum = 0u; cnt = 0u; mine = 0u;
#pragma unroll
        for (unsigned j = 0; j < 16; ++j) { const unsigned c = xb_ld(&bar[XB_XCNT(j)]); sum += c; cnt += (c > 0u) ? 1u : 0u; mine = (j == x) ? c : mine; }
        if (sum == G) break;
        __builtin_amdgcn_s_sleep(1);
        if ((++sp & 255u) == 0u) { if (xb_ld(&bar[XB_TMO])) break; if (sp > XB_SPIN_CAP) { atomicAdd(&bar[XB_TMO], 1u); break; } }
    }
    nloc = mine > 0u ? mine : 1u; nx = cnt > 0u ? cnt : 1u;
}

__device__ __forceinline__ void xcd_barrier(const XcdBarrier& b) {
    asm volatile("s_waitcnt vmcnt(0)" ::: "memory");
    __syncthreads();
    if (threadIdx.x == 0) {
        unsigned* bar = b.bar;
        __builtin_amdgcn_s_waitcnt(0);
        unsigned nloc = b.st[0], nx = b.st[1];
        if (nloc == 0u) { xcd_barrier_complete(bar, b.x, nloc, nx); b.st[0] = nloc; b.st[1] = nx; }
        const unsigned old = xb_add(&bar[XB_XSUB(b.x)], 1u);
        const unsigned gen = old / nloc;
        if (old + 1u == (gen + 1u) * nloc) {
            __builtin_amdgcn_fence(__ATOMIC_RELEASE, "agent");
            asm volatile("s_waitcnt vmcnt(0)" ::: "memory");
            const unsigned og = xb_add(&bar[XB_TOP], 1u);
            const unsigned tg = og / nx;
            if (og + 1u == (tg + 1u) * nx) xb_add(&bar[XB_TOPGEN], 1u);
            else XB_SPIN(xb_ld(&bar[XB_TOPGEN]) == tg, bar);
            __builtin_amdgcn_fence(__ATOMIC_ACQUIRE, "agent");
            xb_add(&bar[XB_XGEN(b.x)], 1u);
            asm volatile("s_waitcnt vmcnt(0)" ::: "memory");
        } else {
            XB_SPIN(xb_ld(&bar[XB_XGEN(b.x)]) == gen, bar);
            __builtin_amdgcn_fence(__ATOMIC_ACQUIRE, "agent");
            asm volatile("s_waitcnt vmcnt(0)" ::: "memory");
        }
    }
    __syncthreads();
}

constexpr int NWAVES = 8;
constexpr int NB = 4, SEQ = 2048, TOK = NB * SEQ, DM = 2048, NPROJ = 4608, INW = 4360, PLED = 256;
constexpr int NEXP = 16, DEXP = 512, SLOTS = 20480, MAXRT = SLOTS / 256;
constexpr int PC_FQ = 0, PC_FK = 512, PC_FV = 1024, PC_DQ = 1536, PC_DK = 2048, PC_DV = 2560, PC_PU = 3072, PC_SQ = 3584, PC_SK = 4096, PC_SV = 4224, PC_FF = 4352;
constexpr float LOG2E = 1.4426950408889634f;
constexpr float C2 = 0.125f * LOG2E;
constexpr float ALPHA = 1.4142135623730951f;
constexpr float LN_EPS = 1e-5f;
constexpr int NPH = 12;

enum { I_X = 0, I_P, I_REL, I_WIN, I_BF, I_LQ1, I_LK1, I_LQ2, I_LK2, I_DNG, I_POOLW, I_POOLS, I_SINK, I_WO, I_LN1G, I_LN1B, I_RGW, I_RGB, I_REW, I_REB, I_WGATE, I_WUP, I_WDOWN, I_PGW, I_PUW, I_LN2G, I_LN2B, N_IN };

constexpr size_t MiB = 1u << 20;
constexpr size_t WS_CTL = 0, CTL_ZERO_BYTES = 1 * MiB;
constexpr size_t WS_KB2 = 1 * MiB;
constexpr size_t WS_TBL = 1 * MiB + 512 * 1024;
constexpr size_t WS_WRT = 2 * MiB;
constexpr size_t WS_LTOK = 3 * MiB;
constexpr size_t WS_LW = 3 * MiB + 512 * 1024;
constexpr size_t WS_TOKE = 4 * MiB;
constexpr size_t WS_TOKP = 4 * MiB + 128 * 1024;
constexpr size_t WS_WIN = 6 * MiB, WS_WO = 24 * MiB, WS_W1 = 32 * MiB, WS_WD = 96 * MiB, WS_WG = 128 * MiB, WS_WU = 136 * MiB;
constexpr size_t WS_XB = 138 * MiB, WS_PB = 170 * MiB;
constexpr size_t WS_A = 178 * MiB;
constexpr size_t WS_B = 258 * MiB;
constexpr size_t WS_C = 322 * MiB;
constexpr size_t WS_H = 386 * MiB, WS_HB = 450 * MiB, WS_END = 482 * MiB;
constexpr int CW_BAR = 4096;
constexpr int CW_CNT = 16384;

constexpr int RING_OFF = 0, RING_BYTES = 131072;
constexpr int LDSCTL_OFF = RING_BYTES, MISC_OFF = LDSCTL_OFF + 320;
constexpr int TAB_OFF = LDSCTL_OFF + 1024;
constexpr int LDS_BYTES = 147456;

static __device__ const unsigned char T5BUCKET[129] = {0, 1, 2, 3, 4, 5, 6, 7, 8, 9, 10, 11, 12, 13, 14, 15, 16, 16, 16, 17, 17, 18, 18, 18, 19, 19, 19, 20, 20, 20, 20, 21, 21, 21, 21, 22, 22, 22, 22, 22, 23, 23, 23, 23, 23, 23, 24, 24, 24, 24, 24, 24, 25, 25, 25, 25, 25, 25, 25, 26, 26, 26, 26, 26, 26, 26, 26, 27, 27, 27, 27, 27, 27, 27, 27, 27, 27, 28, 28, 28, 28, 28, 28, 28, 28, 28, 28, 29, 29, 29, 29, 29, 29, 29, 29, 29, 29, 29, 29, 30, 30, 30, 30, 30, 30, 30, 30, 30, 30, 30, 30, 30, 30, 31, 31, 31, 31, 31, 31, 31, 31, 31, 31, 31, 31, 31, 31, 31, 31};

struct Args { const float* in[N_IN]; float* out; unsigned char* ws; int ph_lo, ph_hi; };

struct Ctx {
    LAS unsigned char* lds; int tid, lane, wave, vcu, G, gw, NGW;
    unsigned char* ws; float* out;
};

__device__ __forceinline__ float wave_sum(float v) {
#pragma unroll
    for (int o = 1; o < 64; o <<= 1) v += __shfl_xor(v, o);
    return v;
}
__device__ __forceinline__ float wave_max(float v) {
#pragma unroll
    for (int o = 1; o < 64; o <<= 1) v = fmaxf(v, __shfl_xor(v, o));
    return v;
}
__device__ __forceinline__ float bf2f(unsigned short b) { return __builtin_bit_cast(float, (unsigned)b << 16); }
__device__ __forceinline__ float bflo(unsigned w) { return __builtin_bit_cast(float, w << 16); }
__device__ __forceinline__ float bfhi(unsigned w) { return __builtin_bit_cast(float, w & 0xffff0000u); }

namespace pg8 {
struct EpiStore {
    static constexpr bool PERM = true, AFTER_DRAIN = false;
    bf16_t* O; int ldc; int pn_mask;
    __device__ __forceinline__ void operator()(const f32x4 (&acc)[2][2][4][2], const Unit& u, int wr, int wc, int fr, int fq) const {
        const int row0 = u.pm * BM + wr * 64 + fr; const int col0 = (u.pn & pn_mask) * BM + wc * 32 + 8 * fq;
#pragma unroll
        for (int ai = 0; ai < 2; ++ai)
#pragma unroll
            for (int m = 0; m < 4; ++m) { bf16_t* rowp = O + (size_t)(row0 + ai * HALF + m * 16) * ldc + col0;
#pragma unroll
                for (int bj = 0; bj < 2; ++bj) { const f32x4 v0 = acc[ai][bj][m][0], v1 = acc[ai][bj][m][1];
                    u32x4 w; w.x = cvt_pk_bf16(v0[0], v0[1]); w.y = cvt_pk_bf16(v0[2], v0[3]); w.z = cvt_pk_bf16(v1[0], v1[1]); w.w = cvt_pk_bf16(v1[2], v1[3]);
                    *(u32x4*)(rowp + bj * HALF) = w; } }
    }
};
struct EpiResF32 {
    static constexpr bool PERM = false, AFTER_DRAIN = false;
    const float* res; float* out; int ldc; float alpha;
    __device__ __forceinline__ void operator()(const f32x4 (&acc)[2][2][4][2], const Unit& u, int wr, int wc, int fr, int fq) const {
        const int col0 = u.pn * BM + wc * 32 + 4 * fq;
#pragma unroll
        for (int ai = 0; ai < 2; ++ai)
#pragma unroll
            for (int m = 0; m < 4; ++m) { const size_t off = (size_t)(u.pm * BM + ai * HALF + wr * 64 + m * 16 + fr) * ldc + col0;
#pragma unroll
                for (int bj = 0; bj < 2; ++bj)
#pragma unroll
                    for (int n = 0; n < 2; ++n) { const f32x4 rs = *(const f32x4*)(res + off + bj * HALF + n * 16); *(f32x4*)(out + off + bj * HALF + n * 16) = acc[ai][bj][m][n] + rs * alpha; } }
    }
};
struct EpiSwiglu {
    static constexpr bool PERM = true, AFTER_DRAIN = false;
    bf16_t* hid; const float* lw; const int* cnt; const __attribute__((address_space(3))) int* ts;
    __device__ __forceinline__ void operator()(const f32x4 (&acc)[2][2][4][2], const Unit& u, int wr, int wc, int fr, int fq) const {
        const int e = u.pn >> 2, j = u.pn & 3; const int pos0 = (u.pm - ts[e]) * BM, ne = cnt[e];
        const int col0 = j * 128 + wc * 32 + 8 * fq;
#pragma unroll
        for (int ai = 0; ai < 2; ++ai)
#pragma unroll
            for (int m = 0; m < 4; ++m) { const int rl = ai * HALF + wr * 64 + m * 16 + fr; const int pos = pos0 + rl;
                const float w = pos < ne ? lw[e * 8192 + pos] : 0.f;
                float r[8];
#pragma unroll
                for (int n = 0; n < 2; ++n)
#pragma unroll
                    for (int i = 0; i < 4; ++i) { const float a = acc[ai][0][m][n][i], up = acc[ai][1][m][n][i]; r[n * 4 + i] = a / (1.f + __expf(-a)) * up * w; }
                u32x4 o; o.x = cvt_pk_bf16(r[0], r[1]); o.y = cvt_pk_bf16(r[2], r[3]); o.z = cvt_pk_bf16(r[4], r[5]); o.w = cvt_pk_bf16(r[6], r[7]);
                *(u32x4*)(hid + (size_t)(u.pm * BM + rl) * 512 + col0) = o; }
    }
};
struct EpiPle {
    static constexpr bool PERM = true, AFTER_DRAIN = false;
    const bf16_t* U; bf16_t* O; int ldc;
    __device__ __forceinline__ void operator()(const f32x4 (&acc)[2][2][4][2], const Unit& u, int wr, int wc, int fr, int fq) const {
        const int row0 = u.pm * BM + wr * 64 + fr; const int col0 = u.pn * BM + wc * 32 + 8 * fq;
#pragma unroll
        for (int ai = 0; ai < 2; ++ai)
#pragma unroll
            for (int m = 0; m < 4; ++m) { const size_t off = (size_t)(row0 + ai * HALF + m * 16) * ldc + col0;
#pragma unroll
                for (int bj = 0; bj < 2; ++bj) { const u32x4 uu = *(const u32x4*)(U + off + bj * HALF); const f32x4 v0 = acc[ai][bj][m][0], v1 = acc[ai][bj][m][1];
                    float r[8];
                    r[0] = __builtin_bit_cast(float, uu.x << 16) / (1.f + __expf(-v0[0])); r[1] = __builtin_bit_cast(float, uu.x & 0xffff0000u) / (1.f + __expf(-v0[1]));
                    r[2] = __builtin_bit_cast(float, uu.y << 16) / (1.f + __expf(-v0[2])); r[3] = __builtin_bit_cast(float, uu.y & 0xffff0000u) / (1.f + __expf(-v0[3]));
                    r[4] = __builtin_bit_cast(float, uu.z << 16) / (1.f + __expf(-v1[0])); r[5] = __builtin_bit_cast(float, uu.z & 0xffff0000u) / (1.f + __expf(-v1[1]));
                    r[6] = __builtin_bit_cast(float, uu.w << 16) / (1.f + __expf(-v1[2])); r[7] = __builtin_bit_cast(float, uu.w & 0xffff0000u) / (1.f + __expf(-v1[3]));
                    u32x4 o; o.x = cvt_pk_bf16(r[0], r[1]); o.y = cvt_pk_bf16(r[2], r[3]); o.z = cvt_pk_bf16(r[4], r[5]); o.w = cvt_pk_bf16(r[6], r[7]);
                    *(u32x4*)(O + off + bj * HALF) = o; } }
    }
};
struct MoeOrder {
    const __attribute__((address_space(3))) int* ts; int ncol, G, c;
    __device__ __forceinline__ bool next(int i, Unit& u) const {
        const int nrt = ts[16]; const int L = i * G + c; if (L >= nrt * ncol) return false;
        const int rt = L / ncol, ct = L - rt * ncol; int e = 0;
#pragma unroll
        for (int j = 1; j < 16; ++j) e += (ts[j] <= rt) ? 1 : 0;
        u.pm = __builtin_amdgcn_readfirstlane(rt); u.pn = __builtin_amdgcn_readfirstlane(e * ncol + ct); return true;
    }
    __device__ __forceinline__ void a_ready(const Unit&) const {}
    __device__ __forceinline__ void done(const Unit&) const {}
};
}

__device__ __forceinline__ void transpose_item(const float* src, int src_ld, int src_col0, int ncols, int k0, bf16* dst, int dst_K, int dst_row0, float scale, LAS float* scr, int lane) {
#pragma unroll 8
    for (int i = 0; i < 32; ++i) { const int kk = 2 * i + (lane >> 5), c = lane & 31;
        float v = 0.f; if (c < ncols) v = src[(size_t)(k0 + kk) * src_ld + src_col0 + c] * scale;
        scr[kk * 33 + c] = v; }
    LDS_WAIT(); asm volatile("" ::: "memory");
    const int c8 = lane & 7;
#pragma unroll
    for (int j = 0; j < 4; ++j) { const int n = (lane >> 3) + 8 * j; const LAS float* s = scr + (8 * c8) * 33 + n;
        v4u o; o.x = pk2(s[0 * 33], s[1 * 33]); o.y = pk2(s[2 * 33], s[3 * 33]); o.z = pk2(s[4 * 33], s[5 * 33]); o.w = pk2(s[6 * 33], s[7 * 33]);
        *(GAS v4u*)(dst + (size_t)(dst_row0 + n) * dst_K + k0 + 8 * c8) = o; }
    LDS_WAIT(); asm volatile("" ::: "memory");
}

__device__ __forceinline__ void ph_prologue(const Ctx& C, const Args& A, int l) {
    LAS float* scr = (LAS float*)(C.lds + RING_OFF + C.wave * 16384);
    unsigned char* ws = C.ws;
    bf16* Win_t = (bf16*)(ws + WS_WIN); bf16* Wo_t = (bf16*)(ws + WS_WO); bf16* W1_t = (bf16*)(ws + WS_W1); bf16* Wd_t = (bf16*)(ws + WS_WD); bf16* Wg_t = (bf16*)(ws + WS_WG); bf16* Wu_t = (bf16*)(ws + WS_WU);
    constexpr int I_WIN_N = 32 * 144, I_WO_N = 32 * 64, I_W1_N = 16 * 32 * 32, I_WD_N = 16 * 8 * 64, I_WG_N = 32 * 64, I_WU_N = 4 * 64;
    constexpr int NITEMS = I_WIN_N + I_WO_N + I_W1_N + I_WD_N + I_WG_N + I_WU_N;
    for (int it = C.gw; it < NITEMS; it += C.NGW) {
        int r = it;
        if (r < I_WIN_N) { const int kb = r / 144, db = r % 144, d0 = db * 32; int sc0, nc;
            if (d0 < 1536) { sc0 = d0; nc = 32; } else if (d0 < 4352) { sc0 = d0 + 8; nc = 32; } else if (d0 == 4352) { sc0 = 1536; nc = 8; } else { sc0 = 0; nc = 0; }
            const bool isq = (d0 < 512) || (d0 >= PC_DQ && d0 < PC_DK) || (d0 >= PC_SQ && d0 < PC_SK);
            transpose_item(A.in[I_WIN] + (size_t)l * DM * INW, INW, sc0, nc, kb * 64, Win_t, DM, d0, isq ? C2 : 1.f, scr, C.lane); continue; }
        r -= I_WIN_N;
        if (r < I_WO_N) { const int kb = r / 64, db = r % 64; transpose_item(A.in[I_WO] + (size_t)l * DM * DM, DM, db * 32, 32, kb * 64, Wo_t, DM, db * 32, 1.f, scr, C.lane); continue; }
        r -= I_WO_N;
        if (r < I_W1_N) { const int e = r >> 10, kb = (r >> 5) & 31, db = r & 31; const int j = db >> 3, within = (db & 7) * 32;
            const float* src = (within < 128 ? A.in[I_WGATE] : A.in[I_WUP]) + (size_t)(l * NEXP + e) * DM * DEXP; const int col = 128 * j + (within & 127);
            transpose_item(src, DEXP, col, 32, kb * 64, W1_t + (size_t)e * 1024 * DM, DM, db * 32, 1.f, scr, C.lane); continue; }
        r -= I_W1_N;
        if (r < I_WD_N) { const int e = r >> 9, kb = (r >> 6) & 7, db = r & 63;
            transpose_item(A.in[I_WDOWN] + (size_t)(l * NEXP + e) * DEXP * DM, DM, db * 32, 32, kb * 64, Wd_t + (size_t)e * DM * DEXP, DEXP, db * 32, 1.f, scr, C.lane); continue; }
        r -= I_WD_N;
        if (r < I_WG_N) { const int kb = r / 64, db = r % 64; transpose_item(A.in[I_PGW] + (size_t)l * DM * DM, DM, db * 32, 32, kb * 64, Wg_t, DM, db * 32, 1.f, scr, C.lane); continue; }
        r -= I_WG_N;
        { const int kb = r / 64, db = r % 64; transpose_item(A.in[I_PUW] + (size_t)l * PLED * DM, DM, db * 32, 32, kb * 64, Wu_t, PLED, db * 32, 1.f, scr, C.lane); }
    }
    const int gt = C.vcu * 512 + C.tid, NT = C.G * 512;
    if (l == 0) {
        const GAS f32x4* x4 = (const GAS f32x4*)A.in[I_X]; GAS v4u* o = (GAS v4u*)(ws + WS_XB);
        for (int i = gt; i < TOK * DM / 8; i += NT) { const f32x4 a = x4[2 * i], b = x4[2 * i + 1]; v4u w; w.x = pk2(a.x, a.y); w.y = pk2(a.z, a.w); w.z = pk2(b.x, b.y); w.w = pk2(b.z, b.w); o[i] = w; }
    }
    {
        const GAS f32x4* p4 = (const GAS f32x4*)(A.in[I_P] + (size_t)l * TOK * PLED); GAS v4u* o = (GAS v4u*)(ws + WS_PB);
        for (int i = gt; i < TOK * PLED / 8; i += NT) { const f32x4 a = p4[2 * i], b = p4[2 * i + 1]; v4u w; w.x = pk2(a.x, a.y); w.y = pk2(a.z, a.w); w.z = pk2(b.x, b.y); w.w = pk2(b.z, b.w); o[i] = w; }
    }
    {
        float* tbl = (float*)(ws + WS_TBL);
        for (int i = gt; i < 12 * 129; i += NT) { const int h = i / 129, d = i % 129; tbl[i] = A.in[I_REL][(int)T5BUCKET[d] * 12 + h] * LOG2E; }
        float* wrt = (float*)(ws + WS_WRT);
        for (int i = gt; i < 20 * DM; i += NT) { const int j = i / DM, k = i % DM; wrt[i] = j < 4 ? A.in[I_RGW][((size_t)l * DM + k) * 4 + j] : A.in[I_REW][((size_t)l * DM + k) * 16 + (j - 4)]; }
    }
}

__device__ __forceinline__ float slow_attn_row(const bf16* proj, int qcol, int kcol, int vcol, int b, int t, int window, const float* kb2, const float* dt, bool has_sink, float sink2, int lane) {
    const bf16* base = proj + (size_t)b * SEQ * NPROJ;
    float q[64];
    { const v4u* qp = (const v4u*)(base + (size_t)t * NPROJ + qcol);
#pragma unroll
      for (int i = 0; i < 8; ++i) { const v4u w = qp[i]; q[8 * i + 0] = bflo(w.x); q[8 * i + 1] = bfhi(w.x); q[8 * i + 2] = bflo(w.y); q[8 * i + 3] = bfhi(w.y); q[8 * i + 4] = bflo(w.z); q[8 * i + 5] = bfhi(w.z); q[8 * i + 6] = bflo(w.w); q[8 * i + 7] = bfhi(w.w); } }
    const int lo = window ? (t - window + 1 > 0 ? t - window + 1 : 0) : 0;
    float mx = -INFINITY;
    for (int s = lo + lane; s <= t; s += 64) {
        const v4u* kp = (const v4u*)(base + (size_t)s * NPROJ + kcol); float d = 0.f;
#pragma unroll
        for (int i = 0; i < 8; ++i) { const v4u w = kp[i]; d += q[8 * i + 0] * bflo(w.x) + q[8 * i + 1] * bfhi(w.x) + q[8 * i + 2] * bflo(w.y) + q[8 * i + 3] * bfhi(w.y) + q[8 * i + 4] * bflo(w.z) + q[8 * i + 5] * bfhi(w.z) + q[8 * i + 6] * bflo(w.w) + q[8 * i + 7] * bfhi(w.w); }
        if (kb2) d += kb2[s];
        if (dt) { const int dd = t - s; d += dt[dd < 128 ? dd : 128]; }
        mx = fmaxf(mx, d);
    }
    mx = wave_max(mx); if (has_sink) mx = fmaxf(mx, sink2);
    float l = 0.f; float o[64];
#pragma unroll
    for (int i = 0; i < 64; ++i) o[i] = 0.f;
    for (int s = lo + lane; s <= t; s += 64) {
        const v4u* kp = (const v4u*)(base + (size_t)s * NPROJ + kcol); float d = 0.f;
#pragma unroll
        for (int i = 0; i < 8; ++i) { const v4u w = kp[i]; d += q[8 * i + 0] * bflo(w.x) + q[8 * i + 1] * bfhi(w.x) + q[8 * i + 2] * bflo(w.y) + q[8 * i + 3] * bfhi(w.y) + q[8 * i + 4] * bflo(w.z) + q[8 * i + 5] * bfhi(w.z) + q[8 * i + 6] * bflo(w.w) + q[8 * i + 7] * bfhi(w.w); }
        if (kb2) d += kb2[s];
        if (dt) { const int dd = t - s; d += dt[dd < 128 ? dd : 128]; }
        const float p = exp2f(d - mx); l += p;
        const v4u* vp = (const v4u*)(base + (size_t)s * NPROJ + vcol);
#pragma unroll
        for (int i = 0; i < 8; ++i) { const v4u w = vp[i]; o[8 * i + 0] += p * bflo(w.x); o[8 * i + 1] += p * bfhi(w.x); o[8 * i + 2] += p * bflo(w.y); o[8 * i + 3] += p * bfhi(w.y); o[8 * i + 4] += p * bflo(w.z); o[8 * i + 5] += p * bfhi(w.z); o[8 * i + 6] += p * bflo(w.w); o[8 * i + 7] += p * bfhi(w.w); }
    }
    l = wave_sum(l); if (has_sink) l += exp2f(sink2 - mx);
#pragma unroll
    for (int st = 0; st < 6; ++st) { const int off = 32 >> st, n = 32 >> st; const bool up = (lane & off) != 0;
#pragma unroll
        for (int i = 0; i < n; ++i) { const float a = o[i], bb = o[i + n]; const float keep = up ? bb : a, send = up ? a : bb; o[i] = keep + __shfl_xor(send, off); } }
    return o[0] / l;
}

__device__ __forceinline__ void ph_mix_a(const Ctx& C, const Args& A, int l) {
    unsigned char* ws = C.ws; const bf16* proj = (const bf16*)(ws + WS_A); bf16* mix = (bf16*)(ws + WS_C); float* dscr = (float*)(ws + WS_C + 32 * MiB);
    float* kb2 = (float*)(ws + WS_KB2); const float* tbl = (const float*)(ws + WS_TBL);
    const int lane = C.lane;
    for (int u = C.gw; u < NB * 8; u += C.NGW) { const int b = u >> 3, h = u & 7; const float bf = A.in[I_BF][l * 8 + h];
        float v[32]; float run = 0.f;
#pragma unroll
        for (int i = 0; i < 32; ++i) { const int s = lane * 32 + i; const float f = bf2f(proj[(size_t)(b * SEQ + s) * NPROJ + PC_FF + h]) + bf;
            const float ls = fminf(f, 0.f) - log1pf(expf(-fabsf(f))); run += ls; v[i] = run; }
        float inc = run;
#pragma unroll
        for (int o = 1; o < 64; o <<= 1) { const float t = __shfl_up(inc, o); if (lane >= o) inc += t; }
        const float excl = inc - run;
#pragma unroll
        for (int i = 0; i < 32; ++i) kb2[(size_t)u * SEQ + lane * 32 + i] = -(excl + v[i]) * LOG2E;
    }
    { LAS float* pw = (LAS float*)(C.lds + RING_OFF + C.wave * 16384);
      const float* W = A.in[I_POOLW] + (size_t)l * 4 * 128 * 128; const float* sc = A.in[I_POOLS] + l * 512;
      for (int t = C.gw; t < TOK; t += C.NGW) { const int tt = t & (SEQ - 1);
#pragma unroll
        for (int i = 0; i < 8; ++i) { const int c = lane + 64 * i, g = c >> 7, w = 2 << g; const int n = tt + 1 < w ? tt + 1 : w; float s = 0.f;
            for (int k = 0; k < n; ++k) s += bf2f(proj[(size_t)(t - k) * NPROJ + PC_PU + c]);
            pw[c] = s / (float)n - bf2f(proj[(size_t)t * NPROJ + PC_PU + c]); }
        LDS_WAIT(); asm volatile("" ::: "memory");
#pragma unroll
        for (int g = 0; g < 4; ++g) { float a0 = 0.f, a1 = 0.f; const float* Wg = W + g * 128 * 128;
            for (int c = 0; c < 128; ++c) { const float pv = pw[g * 128 + c]; a0 += pv * Wg[c * 128 + lane]; a1 += pv * Wg[c * 128 + lane + 64]; }
            mix[(size_t)t * DM + 1024 + g * 128 + lane] = (bf16)f2bf(a0 * sc[g * 128 + lane]); mix[(size_t)t * DM + 1024 + g * 128 + lane + 64] = (bf16)f2bf(a1 * sc[g * 128 + lane + 64]); }
        LDS_WAIT(); asm volatile("" ::: "memory");
      } }
    for (int u = C.gw; u < 8 * TOK; u += C.NGW) { const int h = u / TOK, t = u % TOK, b = t / SEQ, tt = t % SEQ;
        const float r = slow_attn_row(proj, PC_SQ + h * 64, PC_SK + (h >> 2) * 64, PC_SV + (h >> 2) * 64, b, tt, 128, nullptr, tbl + (4 + h) * 129, true, A.in[I_SINK][l * 8 + h] * LOG2E, lane);
        mix[(size_t)t * DM + 1536 + h * 64 + lane] = (bf16)f2bf(r); }
    for (int u = C.gw; u < 16 * TOK; u += C.NGW) { const int hh = u / TOK, t = u % TOK, b = t / SEQ, tt = t % SEQ; const int h = hh >> 2, m = (hh >> 1) & 1, half = hh & 1;
        const float r = slow_attn_row(proj, PC_DQ + (h * 2 + m) * 64, PC_DK + (h * 2 + m) * 64, PC_DV + h * 128 + half * 64, b, tt, 0, nullptr, tbl + h * 129, false, 0.f, lane);
        dscr[((size_t)t * 2 + m) * 512 + h * 128 + half * 64 + lane] = r; }
}
__device__ __forceinline__ void ph_mix_b(const Ctx& C, const Args& A, int l) {
    unsigned char* ws = C.ws; const bf16* proj = (const bf16*)(ws + WS_A); bf16* mix = (bf16*)(ws + WS_C); const float* dscr = (const float*)(ws + WS_C + 32 * MiB);
    const float* kb2 = (const float*)(ws + WS_KB2); const int lane = C.lane;
    for (int u = C.gw; u < 8 * TOK; u += C.NGW) { const int h = u / TOK, t = u % TOK, b = t / SEQ, tt = t % SEQ;
        const float r = slow_attn_row(proj, PC_FQ + h * 64, PC_FK + h * 64, PC_FV + h * 64, b, tt, 0, kb2 + (size_t)(b * 8 + h) * SEQ, nullptr, false, 0.f, lane);
        mix[(size_t)t * DM + h * 64 + lane] = (bf16)f2bf(r); }
    const float lam_init = (l == 0) ? 0.2f : 0.35550907f;
    const float s1 = wave_sum(A.in[I_LQ1][l * 64 + lane] * A.in[I_LK1][l * 64 + lane]), s2 = wave_sum(A.in[I_LQ2][l * 64 + lane] * A.in[I_LK2][l * 64 + lane]);
    const float lam = expf(s1) - expf(s2) + lam_init;
    const float g0 = A.in[I_DNG][l * 128 + lane], g1 = A.in[I_DNG][l * 128 + 64 + lane];
    for (int u = C.gw; u < 4 * TOK; u += C.NGW) { const int h = u & 3, t = u >> 2;
        const float* o0 = dscr + ((size_t)t * 2 + 0) * 512 + h * 128; const float* o1 = dscr + ((size_t)t * 2 + 1) * 512 + h * 128;
        const float d0 = o0[lane] - lam * o1[lane], d1 = o0[lane + 64] - lam * o1[lane + 64];
        const float ms = wave_sum(d0 * d0 + d1 * d1) * (1.f / 128.f); const float r = 1.f / sqrtf(ms + LN_EPS) * (1.f - lam_init);
        mix[(size_t)t * DM + 512 + h * 128 + lane] = (bf16)f2bf(d0 * r * g0); mix[(size_t)t * DM + 512 + h * 128 + 64 + lane] = (bf16)f2bf(d1 * r * g1); }
}

__device__ __forceinline__ void ph_ln1_router(const Ctx& C, const Args& A, int l) {
    unsigned char* ws = C.ws; const float* z = (const float*)(ws + WS_A); float* hf = (float*)(ws + WS_H); bf16* hb = (bf16*)(ws + WS_HB);
    const float* wrt = (const float*)(ws + WS_WRT); unsigned* cnt = (unsigned*)(ws + WS_CTL) + CW_CNT + 64 * l;
    int* ltok = (int*)(ws + WS_LTOK); float* lw = (float*)(ws + WS_LW); int* toke = (int*)(ws + WS_TOKE); int* tokp = (int*)(ws + WS_TOKP);
    const int lane = C.lane; const float* g = A.in[I_LN1G] + l * DM; const float* bb = A.in[I_LN1B] + l * DM;
    for (int t = C.gw; t < TOK; t += C.NGW) {
        const GAS f32x4* zr = (const GAS f32x4*)(z + (size_t)t * DM) + lane; f32x4 v[8]; float s = 0.f;
#pragma unroll
        for (int j = 0; j < 8; ++j) { v[j] = zr[64 * j]; s += (v[j].x + v[j].y) + (v[j].z + v[j].w); }
        const float mean = wave_sum(s) * (1.f / DM); float s2 = 0.f;
#pragma unroll
        for (int j = 0; j < 8; ++j) { v[j] = v[j] - mean; s2 += (v[j].x * v[j].x + v[j].y * v[j].y) + (v[j].z * v[j].z + v[j].w * v[j].w); }
        const float rstd = 1.f / sqrtf(wave_sum(s2) * (1.f / DM) + LN_EPS);
#pragma unroll
        for (int j = 0; j < 8; ++j) { const f32x4 gg = *((const f32x4*)g + lane + 64 * j), bv = *((const f32x4*)bb + lane + 64 * j); v[j] = v[j] * rstd * gg + bv;
            *((GAS f32x4*)(hf + (size_t)t * DM) + lane + 64 * j) = v[j];
            *((GAS unsigned long long*)(hb + (size_t)t * DM) + lane + 64 * j) = (unsigned long long)pk2(v[j].x, v[j].y) | ((unsigned long long)pk2(v[j].z, v[j].w) << 32); }
        float mylg = 0.f;
#pragma unroll 1
        for (int e = 0; e < 20; ++e) { float a = 0.f;
#pragma unroll
            for (int j = 0; j < 8; ++j) { const f32x4 w = *((const f32x4*)(wrt + e * DM) + lane + 64 * j); a += (v[j].x * w.x + v[j].y * w.y) + (v[j].z * w.z + v[j].w * w.w); }
            a = wave_sum(a); if (lane == e) mylg = a; }
        {
            const float* rgb = A.in[I_RGB] + l * 4; const float* reb = A.in[I_REB] + l * 16;
            const float q0 = __shfl(mylg, 0) + rgb[0], q1 = __shfl(mylg, 1) + rgb[1], q2 = __shfl(mylg, 2) + rgb[2], q3 = __shfl(mylg, 3) + rgb[3];
            int gs = 0; float gm = q0;
            if (q1 > gm) { gm = q1; gs = 1; }
            if (q2 > gm) { gm = q2; gs = 2; }
            if (q3 > gm) { gm = q3; gs = 3; }
            const float gp = 1.f / (expf(q0 - gm) + expf(q1 - gm) + expf(q2 - gm) + expf(q3 - gm));
            const float c0 = __shfl(mylg, 4 + gs * 4 + 0) + reb[gs * 4 + 0], c1 = __shfl(mylg, 4 + gs * 4 + 1) + reb[gs * 4 + 1], c2 = __shfl(mylg, 4 + gs * 4 + 2) + reb[gs * 4 + 2], c3 = __shfl(mylg, 4 + gs * 4 + 3) + reb[gs * 4 + 3];
            int i1 = 0; float v1 = c0;
            if (c1 > v1) { v1 = c1; i1 = 1; }
            if (c2 > v1) { v1 = c2; i1 = 2; }
            if (c3 > v1) { v1 = c3; i1 = 3; }
            int i2 = -1; float v2 = -INFINITY;
            if (i1 != 0 && c0 > v2) { v2 = c0; i2 = 0; }
            if (i1 != 1 && c1 > v2) { v2 = c1; i2 = 1; }
            if (i1 != 2 && c2 > v2) { v2 = c2; i2 = 2; }
            if (i1 != 3 && c3 > v2) { v2 = c3; i2 = 3; }
            const float ex = expf(v2 - v1); const float w1 = gp / (1.f + ex), w2 = gp * ex / (1.f + ex);
            const int e1 = gs * 4 + i1, e2 = gs * 4 + i2;
            if (lane == 0) {
            const unsigned p1 = atomicAdd(cnt + e1, 1u), p2 = atomicAdd(cnt + e2, 1u);
            ltok[e1 * 8192 + p1] = t; lw[e1 * 8192 + p1] = w1; ltok[e2 * 8192 + p2] = t; lw[e2 * 8192 + p2] = w2;
            toke[t * 2] = e1; toke[t * 2 + 1] = e2; tokp[t * 2] = (int)p1; tokp[t * 2 + 1] = (int)p2;
            }
        }
    }
}
__device__ __forceinline__ void build_ts(const Ctx& C, int l) {
    LAS int* ts = (LAS int*)(C.lds + TAB_OFF); const unsigned* cnt = (const unsigned*)(C.ws + WS_CTL) + CW_CNT + 64 * l;
    __syncthreads();
    if (C.tid == 0) { int acc = 0; for (int e = 0; e < 16; ++e) { ts[e] = acc; acc += ((int)__hip_atomic_load(cnt + e, __ATOMIC_RELAXED, __HIP_MEMORY_SCOPE_AGENT) + 255) >> 8; } ts[16] = acc; }
    __syncthreads();
}
__device__ __forceinline__ void ph_gather(const Ctx& C, const Args& A, int l) {
    build_ts(C, l);
    const LAS int* ts = (const LAS int*)(C.lds + TAB_OFF); const unsigned* cnt = (const unsigned*)(C.ws + WS_CTL) + CW_CNT + 64 * l;
    const int* ltok = (const int*)(C.ws + WS_LTOK); const bf16* hb = (const bf16*)(C.ws + WS_HB); bf16* hp = (bf16*)(C.ws + WS_A);
    const int nslot = ts[16] * 256;
    for (int s = C.gw; s < nslot; s += C.NGW) { const int rt = s >> 8; int e = 0;
#pragma unroll
        for (int j = 1; j < 16; ++j) e += (ts[j] <= rt) ? 1 : 0;
        const int pos = s - ts[e] * 256; GAS v4u* d = (GAS v4u*)(hp + (size_t)s * DM) + C.lane;
        if (pos < (int)cnt[e]) { const int t = ltok[e * 8192 + pos]; const GAS v4u* sp = (const GAS v4u*)(hb + (size_t)t * DM) + C.lane;
#pragma unroll
            for (int j = 0; j < 4; ++j) d[64 * j] = sp[64 * j]; }
        else {
#pragma unroll
            for (int j = 0; j < 4; ++j) d[64 * j] = (v4u){0u, 0u, 0u, 0u}; }
    }
}
__device__ __forceinline__ void ph_ln2(const Ctx& C, const Args& A, int l) {
    build_ts(C, l);
    const LAS int* ts = (const LAS int*)(C.lds + TAB_OFF);
    unsigned char* ws = C.ws; const float* hf = (const float*)(ws + WS_H); const bf16* ys = (const bf16*)(ws + WS_A); const bf16* ple = (const bf16*)(ws + WS_B + 32 * MiB);
    const int* toke = (const int*)(ws + WS_TOKE); const int* tokp = (const int*)(ws + WS_TOKP); bf16* xb = (bf16*)(ws + WS_XB);
    const int lane = C.lane; const float* g = A.in[I_LN2G] + l * DM; const float* bb = A.in[I_LN2B] + l * DM;
    for (int t = C.gw; t < TOK; t += C.NGW) {
        const int e1 = toke[t * 2], e2 = toke[t * 2 + 1]; const int s1 = ts[e1] * 256 + tokp[t * 2], s2 = ts[e2] * 256 + tokp[t * 2 + 1];
        f32x4 v[8]; float s = 0.f;
#pragma unroll
        for (int j = 0; j < 8; ++j) { const f32x4 hv = *((const GAS f32x4*)(hf + (size_t)t * DM) + lane + 64 * j);
            const unsigned long long a = *((const GAS unsigned long long*)(ys + (size_t)s1 * DM) + lane + 64 * j), b = *((const GAS unsigned long long*)(ys + (size_t)s2 * DM) + lane + 64 * j), c = *((const GAS unsigned long long*)(ple + (size_t)t * DM) + lane + 64 * j);
            const unsigned a0 = (unsigned)a, a1 = (unsigned)(a >> 32), b0 = (unsigned)b, b1 = (unsigned)(b >> 32), c0 = (unsigned)c, c1 = (unsigned)(c >> 32);
            v[j].x = ALPHA * hv.x + (bflo(a0) + bflo(b0)) + bflo(c0); v[j].y = ALPHA * hv.y + (bfhi(a0) + bfhi(b0)) + bfhi(c0);
            v[j].z = ALPHA * hv.z + (bflo(a1) + bflo(b1)) + bflo(c1); v[j].w = ALPHA * hv.w + (bfhi(a1) + bfhi(b1)) + bfhi(c1);
            s += (v[j].x + v[j].y) + (v[j].z + v[j].w); }
        const float mean = wave_sum(s) * (1.f / DM); float q = 0.f;
#pragma unroll
        for (int j = 0; j < 8; ++j) { v[j] = v[j] - mean; q += (v[j].x * v[j].x + v[j].y * v[j].y) + (v[j].z * v[j].z + v[j].w * v[j].w); }
        const float rstd = 1.f / sqrtf(wave_sum(q) * (1.f / DM) + LN_EPS);
#pragma unroll
        for (int j = 0; j < 8; ++j) { const f32x4 gg = *((const f32x4*)g + lane + 64 * j), bv = *((const f32x4*)bb + lane + 64 * j); v[j] = v[j] * rstd * gg + bv;
            *((GAS f32x4*)(C.out + (size_t)t * DM) + lane + 64 * j) = v[j];
            if (l == 0) *((GAS unsigned long long*)(xb + (size_t)t * DM) + lane + 64 * j) = (unsigned long long)pk2(v[j].x, v[j].y) | ((unsigned long long)pk2(v[j].z, v[j].w) << 32); }
    }
}

template <int KIND> __global__ void __launch_bounds__(NWAVES * 64, 2) mk_fwd(Args args) {
    extern __shared__ __attribute__((aligned(16))) unsigned char lds_raw[];
    Ctx C;
    C.lds = (LAS unsigned char*)lds_raw; C.tid = threadIdx.x; C.lane = C.tid & 63; C.wave = __builtin_amdgcn_readfirstlane(C.tid >> 6);
    C.G = gridDim.x; { const int bx = blockIdx.x; C.vcu = (C.G % 8 == 0) ? (bx % 8) * (C.G / 8) + bx / 8 : bx; }
    C.gw = C.vcu * NWAVES + C.wave; C.NGW = C.G * NWAVES; C.ws = args.ws; C.out = args.out;
    unsigned char* ws = args.ws;
    for (int u = C.tid; u < (LDS_BYTES - LDSCTL_OFF) / 4; u += NWAVES * 64) ((LAS unsigned*)(C.lds + LDSCTL_OFF))[u] = 0u;
    __syncthreads();
    const bool multi = (args.ph_hi - args.ph_lo) > 1;
    XcdBarrier bar; bar.bar = (unsigned*)(ws + WS_CTL) + CW_BAR; bar.x = 0; bar.st = nullptr;
    if (multi) bar = xcd_barrier_post((unsigned*)(ws + WS_CTL) + CW_BAR, (volatile LAS unsigned*)(C.lds + MISC_OFF) + 8);

    for (int ph = args.ph_lo; ph < args.ph_hi; ++ph) {
        const int l = ph / NPH; constexpr int k = KIND;
        if constexpr (k == 0) { ph_prologue(C, args, l); }
        else if constexpr (k == 1) {
            pg8::Gemm g{(const pg8::bf16_t*)(ws + WS_XB), (const pg8::bf16_t*)(ws + WS_WIN), TOK, NPROJ, DM}; pg8::StaticOrder S; S.init(TOK, NPROJ, C.G, (int)blockIdx.x);
            pg8::EpiBf16<0> E{(pg8::bf16_t*)(ws + WS_A), NPROJ, nullptr, 0, 0, 1.f};
            pg8::gemm_phase<pg8::EpiBf16<0>, pg8::StaticOrder, true, true>(C.lds + RING_OFF, g, S, E);
        }
        else if constexpr (k == 2) {
            pg8::Gemm g{(const pg8::bf16_t*)(ws + WS_PB), (const pg8::bf16_t*)(ws + WS_WU), TOK, DM, PLED}; pg8::StaticOrder S; S.init(TOK, DM, C.G, (int)blockIdx.x);
            pg8::EpiBf16<0> E{(pg8::bf16_t*)(ws + WS_B), DM, nullptr, 0, 0, 1.f};
            pg8::gemm_phase<pg8::EpiBf16<0>, pg8::StaticOrder, true, true>(C.lds + RING_OFF, g, S, E);
        }
        else if constexpr (k == 3) { ph_mix_a(C, args, l); }
        else if constexpr (k == 4) { ph_mix_b(C, args, l); }
        else if constexpr (k == 5) {
            pg8::Gemm g{(const pg8::bf16_t*)(ws + WS_C), (const pg8::bf16_t*)(ws + WS_WO), TOK, DM, DM}; pg8::StaticOrder S; S.init(TOK, DM, C.G, (int)blockIdx.x);
            pg8::EpiResF32 E{l == 0 ? args.in[I_X] : (const float*)args.out, (float*)(ws + WS_A), DM, ALPHA};
            pg8::gemm_phase<pg8::EpiResF32, pg8::StaticOrder, true, true>(C.lds + RING_OFF, g, S, E);
        }
        else if constexpr (k == 6) { ph_ln1_router(C, args, l); }
        else if constexpr (k == 7) { ph_gather(C, args, l); }
        else if constexpr (k == 8) {
            build_ts(C, l);
            pg8::Gemm g{(const pg8::bf16_t*)(ws + WS_A), (const pg8::bf16_t*)(ws + WS_W1), SLOTS, NEXP * 1024, DM};
            pg8::MoeOrder S{(const LAS int*)(C.lds + TAB_OFF), 4, C.G, (int)blockIdx.x};
            pg8::EpiSwiglu E{(pg8::bf16_t*)(ws + WS_C), (const float*)(ws + WS_LW), (const int*)((const unsigned*)(ws + WS_CTL) + CW_CNT + 64 * l), (const LAS int*)(C.lds + TAB_OFF)};
            pg8::gemm_phase<pg8::EpiSwiglu, pg8::MoeOrder, true, true>(C.lds + RING_OFF, g, S, E);
        }
        else if constexpr (k == 9) {
            build_ts(C, l);
            pg8::Gemm g{(const pg8::bf16_t*)(ws + WS_C), (const pg8::bf16_t*)(ws + WS_WD), SLOTS, NEXP * DM, DEXP};
            pg8::MoeOrder S{(const LAS int*)(C.lds + TAB_OFF), 8, C.G, (int)blockIdx.x};
            pg8::EpiStore E{(pg8::bf16_t*)(ws + WS_A), DM, 7};
            pg8::gemm_phase<pg8::EpiStore, pg8::MoeOrder, true, true>(C.lds + RING_OFF, g, S, E);
        }
        else if constexpr (k == 10) {
            pg8::Gemm g{(const pg8::bf16_t*)(ws + WS_HB), (const pg8::bf16_t*)(ws + WS_WG), TOK, DM, DM}; pg8::StaticOrder S; S.init(TOK, DM, C.G, (int)blockIdx.x);
            pg8::EpiPle E{(const pg8::bf16_t*)(ws + WS_B), (pg8::bf16_t*)(ws + WS_B + 32 * MiB), DM};
            pg8::gemm_phase<pg8::EpiPle, pg8::StaticOrder, true, true>(C.lds + RING_OFF, g, S, E);
        }
        else { ph_ln2(C, args, l); }
        if (ph + 1 < args.ph_hi) xcd_barrier(bar);
    }
}

extern "C" void kernel_launch(void* const* d_in, const int* in_sizes, int n_in, void* d_out, int out_size, void* d_ws, size_t ws_size, hipStream_t stream) {
    static int grid = 0;
    if (grid == 0) {
        if (n_in != N_IN || out_size != TOK * DM || ws_size < WS_END) { fprintf(stderr, "kernel_launch: unexpected shapes n_in %d out %d ws %zu (need %zu)\n", n_in, out_size, ws_size, (size_t)WS_END); grid = -1; return; }
        int dev = 0, cus = 0;
        if (hipGetDevice(&dev) != hipSuccess || hipDeviceGetAttribute(&cus, hipDeviceAttributeMultiprocessorCount, dev) != hipSuccess) { grid = -1; return; }
#define SATTR(K) if (hipFuncSetAttribute((const void*)mk_fwd<K>, hipFuncAttributeMaxDynamicSharedMemorySize, LDS_BYTES) != hipSuccess) { fprintf(stderr, "kernel_launch: hipFuncSetAttribute failed\n"); grid = -1; return; }
        SATTR(0) SATTR(1) SATTR(2) SATTR(3) SATTR(4) SATTR(5) SATTR(6) SATTR(7) SATTR(8) SATTR(9) SATTR(10) SATTR(11)
#undef SATTR
        (void)hipGetLastError();
        grid = cus;
    }
    if (grid < 0) return;
    if (hipMemsetAsync((char*)d_ws + WS_CTL, 0, CTL_ZERO_BYTES, stream) != hipSuccess) return;
    Args a{};
    for (int i = 0; i < N_IN; ++i) a.in[i] = (const float*)d_in[i];
    a.out = (float*)d_out; a.ws = (unsigned char*)d_ws;
    for (int ph = 0; ph < 2 * NPH; ++ph) {
        a.ph_lo = ph; a.ph_hi = ph + 1;
        switch (ph % NPH) {
#define LCH(K) case K: hipLaunchKernelGGL(mk_fwd<K>, dim3(grid), dim3(NWAVES * 64), LDS_BYTES, stream, a); break;
            LCH(0) LCH(1) LCH(2) LCH(3) LCH(4) LCH(5) LCH(6) LCH(7) LCH(8) LCH(9) LCH(10) LCH(11)
#undef LCH
        }
    }
}
```

```cpp
#include <hip/hip_runtime.h>
#include <cstdio>
#include <cstdint>
#include <cmath>
namespace pg8 {
#define PG8_LAS __attribute__((address_space(3)))
typedef unsigned short bf16_t;
typedef short bf16x8 __attribute__((ext_vector_type(8)));
typedef float f32x4 __attribute__((ext_vector_type(4)));
typedef unsigned u32x4 __attribute__((ext_vector_type(4)));
constexpr int BM = 256, BK = 64, HALF = 128, HTB = HALF * BK * 2  , STAGE_BYTES = 8 * HTB, NXCD = 8, WGM = 8;

__host__ __device__ __forceinline__ int lds_byte(int r, int c) { const int st = (r >> 4) * 2 + (c >> 5), rr = r & 15, cc = c & 31, ob = rr * 64 + cc * 2; return st * 1024 + (ob ^ (((ob >> 9) & 1) << 5)); }
__host__ __device__ __forceinline__ void stage_rc(int b, int& R, int& C) { const int st = b / 1024, sb = b % 1024, swz = sb ^ (((sb >> 9) & 1) << 5); R = (st >> 1) * 16 + swz / 64; C = (st & 1) * 32 + (swz % 64) / 2; }
__host__ __device__ __forceinline__ int perm32(int rho) { const int n = rho >> 4, i = rho & 15; return 8 * (i >> 2) + 4 * n + (i & 3); }

struct Unit { int pm, pn; };
struct Gemm { const bf16_t* A; const bf16_t* Bt; int M, N, K; };

struct StaticOrder {
    int nM, nN, nwg, G, c;
    __host__ __device__ void init(int M, int N, int G_, int c_) { nM = M / BM; nN = N / BM; nwg = nM * nN; G = G_; c = c_; }
    __host__ __device__ bool next(int i, Unit& u) const {
        const long L = (long)i * G + c; if (L >= nwg) return false;
        int wgid = (int)L; { const int q = nwg / NXCD, r = nwg % NXCD, xcd = wgid % NXCD, off = wgid / NXCD; wgid = (xcd < r ? xcd * (q + 1) : r * (q + 1) + (xcd - r) * q) + off; }
        const int nig = WGM * nN, gid = wgid / nig, fm = gid * WGM, gsz = (nM - fm) < WGM ? (nM - fm) : WGM;
        u.pm = fm + ((wgid % nig) % gsz); u.pn = (wgid % nig) / gsz; return true;
    }
    __device__ __forceinline__ void a_ready(const Unit&) const {}
    __device__ __forceinline__ void done(const Unit&) const {}
};

__device__ __forceinline__ unsigned cvt_pk_bf16(float lo, float hi) { unsigned r; asm volatile("v_cvt_pk_bf16_f32 %0, %1, %2" : "=v"(r) : "v"(lo), "v"(hi)); return r; }
typedef float f32x2 __attribute__((ext_vector_type(2)));
__device__ __forceinline__ f32x2 gelu_pk(f32x2 v) {
    const f32x2 av = __builtin_elementwise_abs(v), d = av * 0.2316418882f + 1.0f;
    f32x2 t; t.x = __builtin_amdgcn_rcpf(d.x); t.y = __builtin_amdgcn_rcpf(d.y);
    f32x2 q = t * 0.5307027145f + (-0.7265760135f); q = q * t + 0.7107068705f; q = q * t + (-0.142248368f); q = q * t + 0.127414796f; q = q * t;
    const f32x2 s = (v * v) * (-0.72134752044f);
    f32x2 e; e.x = __builtin_amdgcn_exp2f(s.x); e.y = __builtin_amdgcn_exp2f(s.y);
    const f32x2 m = v * (q * e), r = v - m;
    f32x2 o; o.x = v.x < 0.f ? m.x : r.x; o.y = v.y < 0.f ? m.y : r.y; return o;
}

template <int ACT  > struct EpiBf16 {
    static constexpr bool PERM = true, AFTER_DRAIN = false; static_assert(ACT == 0 || ACT == 1, "EpiBf16: ACT is 0 (none) or 1 (gelu_pk)");
    bf16_t* O; int ldc; const float* bias; int split_cols; size_t split_stride; float scale0;
    __device__ __forceinline__ void operator()(const f32x4 (&acc)[2][2][4][2], const Unit& u, int wr, int wc, int fr, int fq) const {
        const int row0 = u.pm * BM + wr * 64 + fr; int colt = u.pn * BM; bf16_t* base = O;
        float sc = 1.f; if (split_cols) { const int t = colt / split_cols; base += (size_t)t * split_stride; colt -= t * split_cols; if (t == 0) sc = scale0; }
        const int col0 = colt + wc * 32 + 8 * fq, bcol0 = u.pn * BM + wc * 32 + 8 * fq;
        f32x4 bv[2][2];
#pragma unroll
        for (int bj = 0; bj < 2; ++bj)
#pragma unroll
            for (int n = 0; n < 2; ++n) bv[bj][n] = bias ? *(const f32x4*)(bias + bcol0 + bj * HALF + 4 * n) : (f32x4){0.f, 0.f, 0.f, 0.f};
#pragma unroll
        for (int ai = 0; ai < 2; ++ai)
#pragma unroll
            for (int m = 0; m < 4; ++m) { bf16_t* rowp = base + (size_t)(row0 + ai * HALF + m * 16) * ldc + col0;
#pragma unroll
                for (int bj = 0; bj < 2; ++bj) { f32x4 v0 = acc[ai][bj][m][0] + bv[bj][0], v1 = acc[ai][bj][m][1] + bv[bj][1];
                    if (ACT == 1) { f32x2 a = gelu_pk((f32x2){v0[0], v0[1]}), b = gelu_pk((f32x2){v0[2], v0[3]}), c = gelu_pk((f32x2){v1[0], v1[1]}), d = gelu_pk((f32x2){v1[2], v1[3]});
                        v0 = (f32x4){a.x, a.y, b.x, b.y}; v1 = (f32x4){c.x, c.y, d.x, d.y}; }
                    v0 = v0 * sc; v1 = v1 * sc; u32x4 w; w.x = cvt_pk_bf16(v0[0], v0[1]); w.y = cvt_pk_bf16(v0[2], v0[3]); w.z = cvt_pk_bf16(v1[0], v1[1]); w.w = cvt_pk_bf16(v1[2], v1[3]);
                    *(u32x4*)(rowp + bj * HALF) = w; } }
    }
};

struct PanelStats {
    unsigned* xbuf;
    unsigned* cnt;
    unsigned* tmo;
    int ntn; float eps;
    unsigned code;
    __device__ __forceinline__ bool run(const f32x4 (&v)[2][2][4][2], const Unit& u, int wr, int wc, int fr, int fq, PG8_LAS unsigned char* lds, int wid, int lane) const {
        typedef float f32x2v __attribute__((ext_vector_type(2)));
        PG8_LAS f32x2v* P = (PG8_LAS f32x2v*)lds;
        PG8_LAS f32x2v* S = (PG8_LAS f32x2v*)(lds + 8192);
        PG8_LAS unsigned* flag = (PG8_LAS unsigned*)(lds + 8192 + 2048);
#pragma unroll
        for (int ai = 0; ai < 2; ++ai)
#pragma unroll
            for (int m = 0; m < 4; ++m) {
                float s = 0.f;
#pragma unroll
                for (int bj = 0; bj < 2; ++bj)
#pragma unroll
                    for (int n = 0; n < 2; ++n) { const f32x4 x = v[ai][bj][m][n]; s += (x[0] + x[1]) + (x[2] + x[3]); }
                s += __shfl_xor(s, 16); s += __shfl_xor(s, 32);
                const float mw = s * (1.0f / 64.0f); float q = 0.f;
#pragma unroll
                for (int bj = 0; bj < 2; ++bj)
#pragma unroll
                    for (int n = 0; n < 2; ++n) { const f32x4 d = v[ai][bj][m][n] - mw; q += (d[0] * d[0] + d[1] * d[1]) + (d[2] * d[2] + d[3] * d[3]); }
                q += __shfl_xor(q, 16); q += __shfl_xor(q, 32);
                if (fq == 0) P[(ai * HALF + wr * 64 + m * 16 + fr) * 4 + wc] = (f32x2v){mw, q};
            }
        asm volatile("s_waitcnt lgkmcnt(0)" ::: "memory"); __builtin_amdgcn_s_barrier(); asm volatile("" ::: "memory");
#if defined(BROKEN_EXCHANGE_NO_WAIT)
#warning BROKEN CONTROL BUILD: the row-statistics exchange does not wait; results are wrong by design
        if (blockIdx.x >= 64) { const long long t0_ = clock64(); while (clock64() - t0_ < 60000) __builtin_amdgcn_s_sleep(8); }
#endif
        const int row = wid * 32 + (lane & 31);
        if (lane < 32) {
            const f32x2v a = P[row * 4 + 0], b = P[row * 4 + 1], c = P[row * 4 + 2], d = P[row * 4 + 3];
            const float mt = (a.x + b.x + c.x + d.x) * 0.25f;
            const float da = a.x - mt, db = b.x - mt, dc = c.x - mt, dd = d.x - mt;
            const float m2 = (a.y + b.y) + (c.y + d.y) + 64.0f * ((da * da + db * db) + (dc * dc + dd * dd));
            unsigned long long* slot = (unsigned long long*)xbuf + ((size_t)(u.pm * BM + row) * 4 + u.pn);
            __hip_atomic_store(slot, ((unsigned long long)__float_as_uint(m2) << 32) | __float_as_uint(mt), __ATOMIC_RELAXED, __HIP_MEMORY_SCOPE_AGENT);
        }
        asm volatile("s_waitcnt vmcnt(0)" ::: "memory");
        if (lane == 0) __hip_atomic_fetch_add(cnt + 64 * u.pm, 1u, __ATOMIC_RELAXED, __HIP_MEMORY_SCOPE_AGENT);
        if (wid == 0) {
            bool dead = false; const unsigned long long t0 = __builtin_amdgcn_s_memrealtime(); const unsigned want = 8u * (unsigned)ntn;
            for (;;) {
#if defined(BROKEN_EXCHANGE_NO_WAIT)
                break;
#endif
                if ((unsigned)__builtin_amdgcn_readfirstlane(__hip_atomic_load(cnt + 64 * u.pm, __ATOMIC_RELAXED, __HIP_MEMORY_SCOPE_AGENT)) >= want) break;
                if (__builtin_amdgcn_s_memrealtime() - t0 > 2000000ull) {
                    if (lane == 0) { unsigned expect = 0u; __hip_atomic_compare_exchange_strong(tmo + 1, &expect, code | (unsigned)(u.pm & 0xff), __ATOMIC_RELAXED, __ATOMIC_RELAXED, __HIP_MEMORY_SCOPE_AGENT);
                                     __hip_atomic_store(tmo, 1u, __ATOMIC_RELAXED, __HIP_MEMORY_SCOPE_AGENT); }
                    dead = true; break; }
                __builtin_amdgcn_s_sleep(2);
            }
            __builtin_amdgcn_fence(__ATOMIC_ACQUIRE, "agent");
            if (lane == 0) flag[0] = dead ? 1u : 0u;
        }
        asm volatile("s_waitcnt vmcnt(0) lgkmcnt(0)" ::: "memory"); __builtin_amdgcn_s_barrier(); asm volatile("" ::: "memory");
        const bool bad = flag[0] != 0u;
        if (lane < 32) {
            const unsigned long long* slot = (const unsigned long long*)xbuf + (size_t)(u.pm * BM + row) * 4; float mt[4], m2[4]; float ms = 0.f;
#pragma unroll
            for (int t = 0; t < 4; ++t) { if (t < ntn) { const unsigned long long w = __hip_atomic_load(slot + t, __ATOMIC_RELAXED, __HIP_MEMORY_SCOPE_AGENT); mt[t] = __uint_as_float((unsigned)w); m2[t] = __uint_as_float((unsigned)(w >> 32)); } else { mt[t] = 0.f; m2[t] = 0.f; } ms += mt[t]; }
            const float mean = ms / (float)ntn; float q = 0.f;
#pragma unroll
            for (int t = 0; t < 4; ++t) if (t < ntn) { const float dm = mt[t] - mean; q += m2[t] + 256.0f * dm * dm; }
            S[row] = (f32x2v){mean, 1.0f / sqrtf(q / (256.0f * (float)ntn) + eps)};
        }
        asm volatile("s_waitcnt lgkmcnt(0)" ::: "memory"); __builtin_amdgcn_s_barrier(); asm volatile("" ::: "memory");
        return bad;
    }
};
struct EpiLnRes {
    static constexpr bool PERM = false, AFTER_DRAIN = true;
    const float* base; float* out; int ldc; const float* bias; PanelStats st; unsigned poison;
    __device__ __forceinline__ void fused(f32x4 (&acc)[2][2][4][2], const Unit& u, int wr, int wc, int fr, int fq, PG8_LAS unsigned char* lds, int wid, int lane) const {
        typedef float f32x2v __attribute__((ext_vector_type(2)));
        const PG8_LAS f32x2v* S = (const PG8_LAS f32x2v*)(lds + 8192);
        const int col0 = u.pn * BM + wc * 32 + 4 * fq;
#pragma unroll
        for (int bj = 0; bj < 2; ++bj)
#pragma unroll
            for (int n = 0; n < 2; ++n) { const f32x4 bv = bias ? *(const f32x4*)(bias + col0 + bj * HALF + n * 16) : (f32x4){0.f, 0.f, 0.f, 0.f};
#pragma unroll
                for (int ai = 0; ai < 2; ++ai)
#pragma unroll
                    for (int m = 0; m < 4; ++m) acc[ai][bj][m][n] += bv; }
        f32x4 pre[4][2][2];
#pragma unroll
        for (int m = 0; m < 4; ++m) { const size_t off = (size_t)(u.pm * BM + wr * 64 + m * 16 + fr) * ldc + col0;
#pragma unroll
            for (int bj = 0; bj < 2; ++bj)
#pragma unroll
                for (int n = 0; n < 2; ++n) pre[m][bj][n] = *(const f32x4*)(base + off + bj * HALF + n * 16); }
        const bool bad = st.run(acc, u, wr, wc, fr, fq, lds, wid, lane) || poison != 0u;
        const float qnan = __builtin_nanf("");
#pragma unroll
        for (int ai = 0; ai < 2; ++ai)
#pragma unroll
            for (int m = 0; m < 4; ++m) { const int r = ai * HALF + wr * 64 + m * 16 + fr; const f32x2v sr = S[r]; const size_t off = (size_t)(u.pm * BM + r) * ldc + col0;
#pragma unroll
                for (int bj = 0; bj < 2; ++bj)
#pragma unroll
                    for (int n = 0; n < 2; ++n) { const f32x4 bs = ai == 0 ? pre[m][bj][n] : *(const f32x4*)(base + off + bj * HALF + n * 16); f32x4 o = bs + (acc[ai][bj][m][n] - sr.x) * sr.y;
                        if (bad) o = (f32x4){qnan, qnan, qnan, qnan}; *(f32x4*)(out + off + bj * HALF + n * 16) = o; }
                if (m & 1) asm volatile("" ::: "memory"); }
    }
};
struct EpiLnResLn {
    static constexpr bool PERM = false, AFTER_DRAIN = true;
    const float* base; float* out; bf16_t* xn; int ldc; const float* bias; PanelStats st1, st2; unsigned poison;
    __device__ __forceinline__ void fused(f32x4 (&acc)[2][2][4][2], const Unit& u, int wr, int wc, int fr, int fq, PG8_LAS unsigned char* lds, int wid, int lane) const {
        typedef float f32x2v __attribute__((ext_vector_type(2))); typedef unsigned u32x2v __attribute__((ext_vector_type(2)));
        const PG8_LAS f32x2v* S = (const PG8_LAS f32x2v*)(lds + 8192);
        const int col0 = u.pn * BM + wc * 32 + 4 * fq;
#pragma unroll
        for (int bj = 0; bj < 2; ++bj)
#pragma unroll
            for (int n = 0; n < 2; ++n) { const f32x4 bv = bias ? *(const f32x4*)(bias + col0 + bj * HALF + n * 16) : (f32x4){0.f, 0.f, 0.f, 0.f};
#pragma unroll
                for (int ai = 0; ai < 2; ++ai)
#pragma unroll
                    for (int m = 0; m < 4; ++m) acc[ai][bj][m][n] += bv; }
        bool bad = st1.run(acc, u, wr, wc, fr, fq, lds, wid, lane) || poison != 0u;
        const float qnan = __builtin_nanf("");
#pragma unroll
        for (int ai = 0; ai < 2; ++ai)
#pragma unroll
            for (int m = 0; m < 4; ++m) { const int r = ai * HALF + wr * 64 + m * 16 + fr; const f32x2v sr = S[r]; const size_t off = (size_t)(u.pm * BM + r) * ldc + col0;
#pragma unroll
                for (int bj = 0; bj < 2; ++bj)
#pragma unroll
                    for (int n = 0; n < 2; ++n) { const f32x4 bs = *(const f32x4*)(base + off + bj * HALF + n * 16); acc[ai][bj][m][n] = bs + (acc[ai][bj][m][n] - sr.x) * sr.y; }
                asm volatile("" : "+v"(acc[ai][0][m][0]), "+v"(acc[ai][0][m][1]), "+v"(acc[ai][1][m][0]), "+v"(acc[ai][1][m][1]));
                if (m & 1) asm volatile("" ::: "memory"); }
        const bool bad1 = bad;
        bad = st2.run(acc, u, wr, wc, fr, fq, lds, wid, lane) || bad;
#pragma unroll
        for (int ai = 0; ai < 2; ++ai)
#pragma unroll
            for (int m = 0; m < 4; ++m) { const int r = ai * HALF + wr * 64 + m * 16 + fr; const f32x2v sr = S[r]; const size_t off = (size_t)(u.pm * BM + r) * ldc + col0;
#pragma unroll
                for (int bj = 0; bj < 2; ++bj)
#pragma unroll
                    for (int n = 0; n < 2; ++n) { const f32x4 x1 = acc[ai][bj][m][n]; *(f32x4*)(out + off + bj * HALF + n * 16) = bad1 ? (f32x4){qnan, qnan, qnan, qnan} : x1;
                        const f32x4 o = (x1 - sr.x) * sr.y; u32x2v w; w.x = cvt_pk_bf16(o[0], o[1]); w.y = cvt_pk_bf16(o[2], o[3]);
                        if (bad) { w.x = 0x7fc07fc0u; w.y = 0x7fc07fc0u; } *(u32x2v*)(xn + off + bj * HALF + n * 16) = w; }
                asm volatile("" ::: "memory"); }
    }
};

template <class Epi, class Sched, bool ALIGN_EPI = false, bool SP2 = false>
__device__ __forceinline__ void gemm_phase(PG8_LAS unsigned char* lds, const Gemm g, const Sched& S, const Epi& E) {
    int tid_ = threadIdx.x; asm volatile("" : "+v"(tid_));
    const int tid = tid_, wid = __builtin_amdgcn_readfirstlane(tid >> 6), lane = tid & 63, wr = wid >> 2, wc = wid & 3, fr = lane & 15, fq = lane >> 4;
    const int K = g.K, nt = K / BK;
    unsigned voffA[2], voffB[2];
#pragma unroll
    for (int i = 0; i < 2; ++i) { int R, C; stage_rc(tid * 16 + i * 8192, R, C); const int Rb = Epi::PERM ? ((R & ~31) + perm32(R & 31)) : R;
        voffA[i] = (unsigned)(R * K + C) * 2u; voffB[i] = (unsigned)(Rb * K + C) * 2u; }
    const size_t kstep = (size_t)(BK * 2);
    const size_t hstep = (size_t)HALF * K * 2;
    const size_t tstep = 2 * hstep;
    const unsigned ldsw = (unsigned)wid * 1024u;
    const int aoff = lds_byte(wr * 64 + fr, fq * 8), boff = lds_byte(wc * 32 + fr, fq * 8);
#define PG8_SA(b, h) (((b) * 2 + (h)) * HTB)
#define PG8_SB(b, h) ((4 + (b) * 2 + (h)) * HTB)
#define PG8_STAGE(bufoff, gbase, voff) do { _Pragma("unroll") for (int _i = 0; _i < 2; ++_i) \
        __builtin_amdgcn_global_load_lds((const unsigned*)((const char*)(gbase) + (voff)[_i]), (PG8_LAS unsigned*)(lds + (bufoff) + ldsw + _i * 8192), 16, 0, 0); } while (0)
#define PG8_LDA(dst, b, h) do { _Pragma("unroll") for (int m = 0; m < 4; ++m) _Pragma("unroll") for (int k = 0; k < 2; ++k) dst[m][k] = *(const PG8_LAS bf16x8*)(lds + PG8_SA(b, h) + aoff + m * 2048 + k * 1024); } while (0)
#define PG8_LDB(dst, b, h) do { _Pragma("unroll") for (int n = 0; n < 2; ++n) _Pragma("unroll") for (int k = 0; k < 2; ++k) dst[n][k] = *(const PG8_LAS bf16x8*)(lds + PG8_SB(b, h) + boff + n * 2048 + k * 1024); } while (0)
#define PG8_MMA(ai, bj, At, Bt) do { __builtin_amdgcn_s_setprio(1); _Pragma("unroll") for (int m = 0; m < 4; ++m) _Pragma("unroll") for (int n = 0; n < 2; ++n) _Pragma("unroll") for (int k = 0; k < 2; ++k) \
        acc[ai][bj][m][n] = __builtin_amdgcn_mfma_f32_16x16x32_bf16(Bt[n][k], At[m][k], acc[ai][bj][m][n], 0, 0, 0); __builtin_amdgcn_s_setprio(0); } while (0)
#define PG8_WAIT_V(n) asm volatile("s_waitcnt vmcnt(" #n ")" ::: "memory")
#define PG8_WAIT_L(n) asm volatile("s_waitcnt lgkmcnt(" #n ")" ::: "memory")
#define PG8_BAR __builtin_amdgcn_s_barrier()
#define PG8_SCHED __builtin_amdgcn_sched_barrier(0)
    Unit cur, nxt; int ui = 0;
    if (!S.next(0, cur)) return;
    f32x4 acc[2][2][4][2];
#pragma unroll
    for (int a = 0; a < 2; ++a)
#pragma unroll
        for (int b = 0; b < 2; ++b)
#pragma unroll
            for (int m = 0; m < 4; ++m)
#pragma unroll
                for (int n = 0; n < 2; ++n) acc[a][b][m][n] = (f32x4){0.f, 0.f, 0.f, 0.f};
    bf16x8 At[4][2], B0[2][2], B1[2][2];
    const char* cA = (const char*)g.A + (size_t)cur.pm * tstep; const char* cB = (const char*)g.Bt + (size_t)cur.pn * tstep;
    S.a_ready(cur);
    if constexpr (SP2) {
        PG8_STAGE(PG8_SB(0, 0), cB, voffB); PG8_STAGE(PG8_SB(0, 1), cB + hstep, voffB); PG8_STAGE(PG8_SA(0, 0), cA, voffA); PG8_STAGE(PG8_SA(0, 1), cA + hstep, voffA);
        if (wr == 1) PG8_BAR;
        PG8_WAIT_V(2); PG8_BAR;
        PG8_STAGE(PG8_SB(1, 0), cB + kstep, voffB); PG8_STAGE(PG8_SA(1, 0), cA + kstep, voffA); PG8_STAGE(PG8_SB(1, 1), cB + hstep + kstep, voffB);
        PG8_WAIT_V(6); PG8_BAR;
    } else {
        PG8_STAGE(PG8_SB(0, 0), cB, voffB); PG8_STAGE(PG8_SA(0, 0), cA, voffA); PG8_STAGE(PG8_SB(0, 1), cB + hstep, voffB); PG8_STAGE(PG8_SA(0, 1), cA + hstep, voffA);
        if (wr == 1) PG8_BAR;
        PG8_WAIT_V(4); PG8_BAR;
        PG8_STAGE(PG8_SB(1, 0), cB + kstep, voffB); PG8_STAGE(PG8_SA(1, 0), cA + kstep, voffA); PG8_STAGE(PG8_SB(1, 1), cB + hstep + kstep, voffB);
        PG8_WAIT_V(6); PG8_BAR;
    }
    for (;;) {
        const bool has_next = S.next(ui + 1, nxt);
        const char* nA = has_next ? (const char*)g.A + (size_t)nxt.pm * tstep : cA; const char* nB = has_next ? (const char*)g.Bt + (size_t)nxt.pn * tstep : cB;
        for (int t = 0; t < nt; t += 2) {
            const bool last = (t == nt - 2);
            const char* a1 = cA + (size_t)(t + 1) * kstep;
            const char* a2 = last ? nA : cA + (size_t)(t + 2) * kstep; const char* b2 = last ? nB : cB + (size_t)(t + 2) * kstep;
            const char* a3 = a2 + kstep; const char* b3 = b2 + kstep;
            if (last && has_next) S.a_ready(nxt);
            if constexpr (SP2) {
            PG8_LDB(B0, 0, 0); PG8_LDB(B1, 0, 1); PG8_SCHED; PG8_LDA(At, 0, 0); PG8_STAGE(PG8_SA(1, 1), a1 + hstep, voffA);
            PG8_WAIT_V(8); PG8_WAIT_L(0); PG8_BAR; PG8_MMA(0, 0, At, B0); PG8_MMA(0, 1, At, B1); PG8_BAR; PG8_SCHED;
            PG8_LDA(At, 0, 1); PG8_STAGE(PG8_SB(0, 0), b2, voffB); PG8_STAGE(PG8_SB(0, 1), b2 + hstep, voffB); PG8_STAGE(PG8_SA(0, 0), a2, voffA);
            PG8_WAIT_V(8); PG8_WAIT_L(0); PG8_BAR; PG8_MMA(1, 0, At, B0); PG8_MMA(1, 1, At, B1); PG8_BAR; PG8_SCHED;
            PG8_LDB(B0, 1, 0); PG8_LDB(B1, 1, 1); PG8_SCHED; PG8_LDA(At, 1, 0); PG8_STAGE(PG8_SA(0, 1), a2 + hstep, voffA);
            PG8_WAIT_V(8); PG8_WAIT_L(0); PG8_BAR; PG8_MMA(0, 0, At, B0); PG8_MMA(0, 1, At, B1); PG8_BAR; PG8_SCHED;
            PG8_LDA(At, 1, 1); PG8_STAGE(PG8_SB(1, 0), b3, voffB); PG8_STAGE(PG8_SB(1, 1), b3 + hstep, voffB); PG8_STAGE(PG8_SA(1, 0), a3, voffA);
            PG8_WAIT_V(8); PG8_WAIT_L(0); PG8_BAR; PG8_MMA(1, 0, At, B0); PG8_MMA(1, 1, At, B1); PG8_BAR; PG8_SCHED;
            } else {
            PG8_LDB(B0, 0, 0); PG8_SCHED; PG8_LDA(At, 0, 0); PG8_STAGE(PG8_SA(1, 1), a1 + hstep, voffA);
            PG8_WAIT_L(8); PG8_BAR; PG8_WAIT_L(0); PG8_MMA(0, 0, At, B0); PG8_BAR; PG8_SCHED;
            PG8_LDB(B1, 0, 1); PG8_STAGE(PG8_SB(0, 0), b2, voffB);
            PG8_BAR; PG8_WAIT_L(0); PG8_MMA(0, 1, At, B1); PG8_BAR;
            PG8_LDA(At, 0, 1); PG8_STAGE(PG8_SA(0, 0), a2, voffA);
            PG8_BAR; PG8_WAIT_L(0); PG8_MMA(1, 0, At, B0); PG8_BAR; PG8_SCHED;
            PG8_STAGE(PG8_SB(0, 1), b2 + hstep, voffB);
            PG8_WAIT_V(6); PG8_BAR; PG8_MMA(1, 1, At, B1); PG8_BAR;
            PG8_LDB(B0, 1, 0); PG8_SCHED; PG8_LDA(At, 1, 0); PG8_STAGE(PG8_SA(0, 1), a2 + hstep, voffA);
            PG8_WAIT_L(8); PG8_BAR; PG8_WAIT_L(0); PG8_MMA(0, 0, At, B0); PG8_BAR; PG8_SCHED;
            PG8_LDB(B1, 1, 1); PG8_STAGE(PG8_SB(1, 0), b3, voffB);
            PG8_BAR; PG8_WAIT_L(0); PG8_MMA(0, 1, At, B1); PG8_BAR;
            PG8_LDA(At, 1, 1); PG8_STAGE(PG8_SA(1, 0), a3, voffA);
            PG8_BAR; PG8_WAIT_L(0); PG8_MMA(1, 0, At, B0); PG8_BAR; PG8_SCHED;
            PG8_STAGE(PG8_SB(1, 1), b3 + hstep, voffB);
            PG8_WAIT_V(6); PG8_BAR; PG8_MMA(1, 1, At, B1); PG8_BAR;
            }
        }
        if constexpr (ALIGN_EPI) { if (wr == 0) PG8_BAR; }
        if constexpr (!Epi::AFTER_DRAIN) { E(acc, cur, wr, wc, fr, fq); S.done(cur); }
        if (!has_next) break;
#pragma unroll
        for (int a = 0; a < 2; ++a)
#pragma unroll
            for (int b = 0; b < 2; ++b)
#pragma unroll
                for (int m = 0; m < 4; ++m)
#pragma unroll
                    for (int n = 0; n < 2; ++n) acc[a][b][m][n] = (f32x4){0.f, 0.f, 0.f, 0.f};
        cur = nxt; cA = nA; cB = nB; ++ui;
        if constexpr (ALIGN_EPI) { if (wr == 1) PG8_BAR; }
    }
    PG8_WAIT_V(0);
    if constexpr (!ALIGN_EPI) { if (wr == 0) PG8_BAR; }
    PG8_BAR;
    if constexpr (Epi::AFTER_DRAIN) { E.fused(acc, cur, wr, wc, fr, fq, lds, wid, lane); S.done(cur); }
#undef PG8_SA
#undef PG8_SB
#undef PG8_STAGE
#undef PG8_LDA
#undef PG8_LDB
#undef PG8_MMA
#undef PG8_WAIT_V
#undef PG8_WAIT_L
#undef PG8_BAR
#undef PG8_SCHED
}
}
#include <hip/hip_bf16.h>
#include <cmath>
namespace attn_body {
using bf16=__hip_bfloat16;
using bf16x8=__attribute__((ext_vector_type(8)))short;
using s16x4=__attribute__((ext_vector_type(4)))short;
using f32x16=__attribute__((ext_vector_type(16)))float;
using u32x4=__attribute__((ext_vector_type(4)))unsigned;
constexpr int D=64,DM=4608;
constexpr int NW=8,QBLK=32,QB=QBLK*NW,KVBLK=64;
constexpr int M_KB=1,M_DIST=2,M_WIN=4;
constexpr int ATTN_PITCH=DM, ATTN_UNIT_ROWS=QB;
__device__ __forceinline__ int crow(int r,int hi){return (r&3)+8*(r>>2)+4*hi;}
#define SBAR() __builtin_amdgcn_sched_barrier(0)
__device__ __forceinline__ void cmask(f32x16&p0,f32x16&p1,int jb,int qrel,int hi){
  const float NEG=-INFINITY; int kb=64*jb+4*hi;
  #pragma unroll
  for(int r=0;r<16;++r){int kv=kb+(r&3)+8*(r>>2); if(kv>qrel)p0[r]=NEG; if(kv+32>qrel)p1[r]=NEG;}
}

typedef __attribute__((address_space(3))) const float* lds_fptr;
typedef float f32x4_t __attribute__((ext_vector_type(4)));
template<int MODE> __device__ __forceinline__ void fix_tile(f32x16&p0,f32x16&p1,int kvoff,int qrel,int hi,lds_fptr dtl){
  const float NEG=-INFINITY;
  int db=qrel-kvoff-4*hi; asm volatile("":"+v"(db));
  if constexpr((MODE&M_DIST)!=0){ if(kvoff>-192){
    #pragma unroll
    for(int r=0;r<16;++r){int d0=db-((r&3)+8*(r>>2)); int d1=d0-32; d0=d0<0?0:(d0>128?128:d0); d1=d1<0?0:(d1>128?128:d1); p0[r]+=dtl[d0]; p1[r]+=dtl[d1]; if((r&3)==3)__builtin_amdgcn_sched_barrier(0);} } }
  if(kvoff>=0){
    #pragma unroll
    for(int r=0;r<16;++r){const int d0=db-((r&3)+8*(r>>2)); if(d0<0)p0[r]=NEG; if(d0<32)p1[r]=NEG;} }
  if constexpr((MODE&M_WIN)!=0){ {
    #pragma unroll
    for(int r=0;r<16;++r){const int d0=db-((r&3)+8*(r>>2)); if(d0>=128)p0[r]=NEG; if(d0-32>=128)p1[r]=NEG;} } }
}
__device__ __forceinline__ void kbias(f32x16&p0,f32x16&p1,lds_fptr kp,int hi){
  #pragma unroll
  for(int g=0;g<4;++g){ const f32x4_t a=*(const __attribute__((address_space(3))) f32x4_t*)(kp+4*hi+8*g), b=*(const __attribute__((address_space(3))) f32x4_t*)(kp+32+4*hi+8*g);
    #pragma unroll
    for(int i=0;i<4;++i){p0[4*g+i]+=a[i];p1[4*g+i]+=b[i];} __builtin_amdgcn_sched_barrier(0); }
}

constexpr int NSLOT=3, SLOTB=8192;
constexpr int LDS_K=0, LDS_V=NSLOT*SLOTB, LDS_WS=2*NSLOT*SLOTB, LDS_OST=LDS_WS+NW*64*4, LDS_BYTES=LDS_OST+NW*4096;
constexpr float C2=0.125f*1.4426950408889634f;
__device__ __forceinline__ void glds16(const void*gsrc,unsigned lds_dst){unsigned keep;
  asm volatile("s_mov_b32 %0, m0\n\ts_mov_b32 m0, %2\n\ts_nop 0\n\tglobal_load_lds_dwordx4 %1, off\n\ts_mov_b32 m0, %0":"=&s"(keep):"v"(gsrc),"s"(lds_dst):"memory");}
__device__ __forceinline__ float max3f(float a,float b,float c){float r;asm("v_max3_f32 %0, %1, %2, %3":"=v"(r):"v"(a),"v"(b),"v"(c));return r;}
__device__ __forceinline__ float max2f(float a,float b){float r;asm("v_max_f32_e32 %0, %1, %2":"=v"(r):"v"(a),"v"(b));return r;}
__device__ __forceinline__ float fadd_s(float a,float b){float r;asm("v_add_f32_e32 %0, %1, %2":"=v"(r):"v"(a),"v"(b));return r;}
__device__ __forceinline__ float fsub_s(float a,float b){float r;asm("v_sub_f32_e32 %0, %1, %2":"=v"(r):"v"(a),"v"(b));return r;}
typedef float f32x2_t __attribute__((ext_vector_type(2))); typedef __bf16 bf16x2_t __attribute__((ext_vector_type(2)));
__device__ __forceinline__ unsigned cvtpk_s(float lo,float hi){f32x2_t v={lo,hi};bf16x2_t b=__builtin_convertvector(v,bf16x2_t);return __builtin_bit_cast(unsigned,b);}
#define WAIT_BAR(N) asm volatile("s_waitcnt vmcnt(" #N ") lgkmcnt(0)\n\ts_barrier":::"memory")

__device__ __forceinline__ void qkt(f32x16&p0,f32x16&p1,const char*Kslot,const bf16x8*qr,const f32x16&negm,int r32,int hi){
  const char*kb=Kslot+hi*1024+r32*16;
  #pragma unroll
  for(int d0=0;d0<4;++d0){
    const bf16x8 b0=*reinterpret_cast<const bf16x8*>(kb+d0*2048);
    const bf16x8 b1=*reinterpret_cast<const bf16x8*>(kb+d0*2048+512);
    if(d0==0){p0=__builtin_amdgcn_mfma_f32_32x32x16_bf16(b0,qr[0],negm,0,0,0);p1=__builtin_amdgcn_mfma_f32_32x32x16_bf16(b1,qr[0],negm,0,0,0);}
    else{p0=__builtin_amdgcn_mfma_f32_32x32x16_bf16(b0,qr[d0],p0,0,0,0);p1=__builtin_amdgcn_mfma_f32_32x32x16_bf16(b1,qr[d0],p1,0,0,0);}}
}
typedef __attribute__((address_space(3))) const char* lds_cptr;
typedef short v4i16_t __attribute__((ext_vector_type(4)));
__device__ __forceinline__ void kload8(bf16x8*kf,lds_cptr kp){
  kf[0]=*(const __attribute__((address_space(3))) bf16x8*)(kp);      kf[1]=*(const __attribute__((address_space(3))) bf16x8*)(kp+512);
  kf[2]=*(const __attribute__((address_space(3))) bf16x8*)(kp+2048); kf[3]=*(const __attribute__((address_space(3))) bf16x8*)(kp+2560);
  kf[4]=*(const __attribute__((address_space(3))) bf16x8*)(kp+4096); kf[5]=*(const __attribute__((address_space(3))) bf16x8*)(kp+4608);
  kf[6]=*(const __attribute__((address_space(3))) bf16x8*)(kp+6144); kf[7]=*(const __attribute__((address_space(3))) bf16x8*)(kp+6656);
}
__device__ __forceinline__ void kload2(bf16x8*kf,lds_cptr kp,int j){ kf[2*j]=*(const __attribute__((address_space(3))) bf16x8*)(kp+j*2048); kf[2*j+1]=*(const __attribute__((address_space(3))) bf16x8*)(kp+j*2048+512); }
__device__ __forceinline__ s16x4 vtr(lds_cptr p){ return __builtin_bit_cast(s16x4,__builtin_amdgcn_ds_read_tr16_b64_v4i16((__attribute__((address_space(3))) v4i16_t*)p)); }
__device__ __forceinline__ float rowmax(const f32x16&p0,const f32x16&p1){
  float a=max3f(p0[0],p0[1],p1[0]),b=max3f(p0[2],p0[3],p1[1]);a=max3f(a,p1[2],p1[3]);
  #pragma unroll
  for(int r=4;r<16;r+=4){a=max3f(a,p0[r],p0[r+1]);b=max3f(b,p0[r+2],p0[r+3]);a=max3f(a,p1[r],p1[r+1]);b=max3f(b,p1[r+2],p1[r+3]);}
  const float m=max2f(a,b);
  auto rr=__builtin_amdgcn_permlane32_swap(__float_as_uint(m),__float_as_uint(m),false,false);
  return max2f(__uint_as_float(rr[0]),__uint_as_float(rr[1]));
}
__device__ __forceinline__ void pv(f32x16*o,int vb,bf16x8 pa0,bf16x8 pa1,bf16x8 pa2,bf16x8 pa3){
  #pragma unroll
  for(int d0=0;d0<2;++d0){s16x4 lo[4],hi[4];
    #pragma unroll
    for(int ks=0;ks<4;++ks){
      asm volatile("ds_read_b64_tr_b16 %0,%1 offset:%c2":"=&v"(lo[ks]):"v"(vb),"i"(d0*4096+ks*1024):"memory");
      asm volatile("ds_read_b64_tr_b16 %0,%1 offset:%c2":"=&v"(hi[ks]):"v"(vb),"i"(d0*4096+ks*1024+512):"memory");}
    asm volatile("s_waitcnt lgkmcnt(0)":::"memory");SBAR();
    #define PK(k) (bf16x8){lo[k][0],lo[k][1],lo[k][2],lo[k][3],hi[k][0],hi[k][1],hi[k][2],hi[k][3]}
    o[d0]=__builtin_amdgcn_mfma_f32_32x32x16_bf16(pa0,PK(0),o[d0],0,0,0);
    o[d0]=__builtin_amdgcn_mfma_f32_32x32x16_bf16(pa1,PK(1),o[d0],0,0,0);
    o[d0]=__builtin_amdgcn_mfma_f32_32x32x16_bf16(pa2,PK(2),o[d0],0,0,0);
    o[d0]=__builtin_amdgcn_mfma_f32_32x32x16_bf16(pa3,PK(3),o[d0],0,0,0);
    #undef PK
  }
}

#ifndef ATTN_STORE16
#define ATTN_STORE16(p,v) (*(u32x4*)(p)=(v))
#endif
template<int MODE,int THRL> __device__ __forceinline__ void attn_unit(const bf16*Qg,const bf16*__restrict__ Kg,const bf16*__restrict__ Vg,bf16*Og,int opitch,int q0,int t_first,int NT,lds_fptr kbl,lds_fptr dtl,float sink2,char*shm){
  int tid_=threadIdx.x; asm volatile("":"+v"(tid_));
  const int tid=tid_,lane=tid&63,r32=lane&31,hi=lane>>5; const int wid=__builtin_amdgcn_readfirstlane(tid>>6);
  const bf16*Qw=Qg+(long)(q0+wid*QBLK)*DM;
  const bf16*Kh=Kg+(long)t_first*KVBLK*DM,*Vh=Vg+(long)t_first*KVBLK*DM;
  const unsigned lds0=(unsigned)(uintptr_t)shm;
  float*wsf=(float*)(shm+LDS_WS)+wid*64;
  const bf16*ksrc=Kh+(long)lane*DM+wid*8;
  const bf16*vsrc=Vh+(long)(16*(wid&3)+(lane>>2))*DM+(wid>>2)*32+(lane&3)*8;
  const unsigned kdst=lds0+LDS_K+wid*1024, vdst=lds0+LDS_V+wid*1024;
  #define DMA_K(t,slot) glds16(ksrc+(long)(t)*KVBLK*DM,(unsigned)__builtin_amdgcn_readfirstlane(kdst+(slot)))
  #define DMA_V(t,slot) glds16(vsrc+(long)(t)*KVBLK*DM,(unsigned)__builtin_amdgcn_readfirstlane(vdst+(slot)))
  const int vb0=(int)(lds0+LDS_V)+((lane>>4)&1)*32+(lane&3)*8+(4*hi+((lane&15)>>2))*64;
  const char*Kbase=shm+LDS_K; bf16x8 kf[8];
  const lds_cptr shm3=(lds_cptr)shm; const lds_cptr kp0=shm3+LDS_K+hi*1024+r32*16; const lds_cptr vp0=shm3+LDS_V+((lane>>4)&1)*32+(lane&3)*8+(4*hi+((lane&15)>>2))*64;
  DMA_K(0,0);DMA_V(0,0);DMA_K(1,SLOTB);
  bf16x8 qr[4];
  #pragma unroll
  for(int d0=0;d0<4;++d0)qr[d0]=*reinterpret_cast<const bf16x8*>(&Qw[(long)r32*DM+d0*16+hi*8]);
  float mhat=0.f,l_reg=0.f;f32x16 o[2];o[0]=f32x16{};o[1]=f32x16{};f32x16 negm=f32x16{};asm volatile("":"+v"(negm));
  const int qrel=wid*QBLK+r32;
  #define CMASK(P0,P1,t) do{ if constexpr((MODE&M_KB)!=0) kbias(P0,P1,kbl+64*((t)+t_first),hi); fix_tile<MODE>(P0,P1,64*((t)+t_first)-q0,qrel,hi,dtl); }while(0)
  #define KBONLY(P0,P1,t) do{ if constexpr((MODE&M_KB)!=0) kbias(P0,P1,kbl+64*((t)+t_first),hi); }while(0)
  bool unset=false;
  bool resc=false;
  #define START(P0,P1) do{ const float rm=rowmax(P0,P1); resc=false; \
    { float dl=rm; if constexpr((MODE&M_WIN)!=0){ unset=!(rm>-INFINITY); dl=unset?0.f:rm; } mhat=fadd_s(mhat,dl); \
      _Pragma("unroll") for(int r=0;r<16;++r){P0[r]=fsub_s(P0[r],dl);P1[r]=fsub_s(P1[r],dl);} \
      _Pragma("unroll") for(int r=0;r<16;++r)negm[r]=-mhat; asm volatile("":"+v"(negm)); } \
    _Pragma("unroll") for(int r=0;r<16;++r)P0[r]=__builtin_amdgcn_exp2f(P0[r]); }while(0)
  #define RESC() do{ if(resc){ asm volatile("s_waitcnt lgkmcnt(0)":::"memory"); \
      _Pragma("unroll") for(int d_=0;d_<2;++d_) _Pragma("unroll") for(int r=0;r<16;++r)o[d_][r]*=wsf[crow(r,hi)]; } }while(0)
  f32x16 pA0,pA1,pB0,pB1;
  int sl_prev=0,sl_cur=0,sl_next=SLOTB;
  #define ROT() do{sl_prev=sl_cur;sl_cur=sl_next;sl_next=(sl_next==(NSLOT-1)*SLOTB)?0:sl_next+SLOTB;}while(0)
  DMA_K(2,2*SLOTB);
  WAIT_BAR(3);
  qkt(pA0,pA1,Kbase,qr,negm,r32,hi);asm volatile("s_nop 15\n\ts_nop 7":"+v"(pA0),"+v"(pA1));CMASK(pA0,pA1,0);
  START(pA0,pA1);
  _Pragma("unroll") for(int r=0;r<16;++r)pA1[r]=__builtin_amdgcn_exp2f(pA1[r]);
  WAIT_BAR(0);
  DMA_K(3,0);DMA_V(1,SLOTB);
  ROT();
  kload8(kf,kp0+sl_cur);
  WAIT_BAR(2);
  s16x4 vlo[8],vhi[8]; u32x4 pw0,pw1,pw2,pw3;
  #define PKW(P,B) cvtpk_s(P[B],P[B+1])
  #define PAF(k) __builtin_bit_cast(bf16x8,pw##k)
  #define VFR(i) (bf16x8){vlo[i][0],vlo[i][1],vlo[i][2],vlo[i][3],vhi[i][0],vhi[i][1],vhi[i][2],vhi[i][3]}
  #define PIN(x) asm volatile("":"+v"(x))
  #define MX3(a,b,c) __builtin_fmaxf(__builtin_fmaxf((a),(b)),(c))
  #define GAPA(MF,A0,A1,A2,A3,W0,W1,PW) do{ MF; sacc+=A0; sacc+=A1; sacc+=A2; sacc+=A3; PIN(sacc); W0; W1; PIN(PW); SBAR(); }while(0)
  #define EX(v) __builtin_amdgcn_exp2f(v)
  #define GAPB(MF,X,B) do{ MF; X[B]=EX(X[B]); X[B+1]=EX(X[B+1]); X[B+2]=EX(X[B+2]); X[B+3]=EX(X[B+3]); PIN(X); SBAR(); }while(0)
  #define VRD(i) do{ vlo[i]=vtr(vp_+(((i)>>2)*4096+((i)&3)*1024)); vhi[i]=vtr(vp_+(((i)>>2)*4096+((i)&3)*1024+512)); }while(0)
  #define KRD(G,j) do{ if(G){ kload2(kf,kp0+sl_next,j); SBAR(); } }while(0)
  #define STEP(C0,C1,P0,P1,t,GK,GV,GL) do{ SBAR(); \
    const lds_cptr vp_=vp0+sl_prev; \
    VRD(0); SBAR(); float sacc=(P0[0]+P0[1]); \
    GAPA(C0=__builtin_amdgcn_mfma_f32_32x32x16_bf16(kf[0],qr[0],negm,0,0,0), P0[2],P0[3],P0[4],P0[5],     pw0[0]=PKW(P0,0), pw0[1]=PKW(P0,2), pw0); \
    VRD(4); SBAR(); GAPA(C1=__builtin_amdgcn_mfma_f32_32x32x16_bf16(kf[1],qr[0],negm,0,0,0), P0[6],P0[7],P0[8],P0[9],     pw0[2]=PKW(P0,4), pw0[3]=PKW(P0,6), pw0); \
    VRD(1); SBAR(); GAPA(C0=__builtin_amdgcn_mfma_f32_32x32x16_bf16(kf[2],qr[1],C0,0,0,0),   P0[10],P0[11],P0[12],P0[13], pw1[0]=PKW(P0,8), pw1[1]=PKW(P0,10), pw1); \
    VRD(5); SBAR(); GAPA(C1=__builtin_amdgcn_mfma_f32_32x32x16_bf16(kf[3],qr[1],C1,0,0,0),   P0[14],P0[15],P1[0],P1[1],   pw1[2]=PKW(P0,12),pw1[3]=PKW(P0,14), pw1); \
    VRD(2); SBAR(); GAPA(C0=__builtin_amdgcn_mfma_f32_32x32x16_bf16(kf[4],qr[2],C0,0,0,0),   P1[2],P1[3],P1[4],P1[5],     pw2[0]=PKW(P1,0), pw2[1]=PKW(P1,2), pw2); \
    VRD(6); SBAR(); GAPA(C1=__builtin_amdgcn_mfma_f32_32x32x16_bf16(kf[5],qr[2],C1,0,0,0),   P1[6],P1[7],P1[8],P1[9],     pw2[2]=PKW(P1,4), pw2[3]=PKW(P1,6), pw2); \
    VRD(3); SBAR(); GAPA(C0=__builtin_amdgcn_mfma_f32_32x32x16_bf16(kf[6],qr[3],C0,0,0,0),   P1[10],P1[11],P1[12],P1[13], pw3[0]=PKW(P1,8), pw3[1]=PKW(P1,10), pw3); \
    VRD(7); SBAR(); GAPA(C1=__builtin_amdgcn_mfma_f32_32x32x16_bf16(kf[7],qr[3],C1,0,0,0),   P1[14],P1[15],0.f,0.f,       pw3[2]=PKW(P1,12),pw3[3]=PKW(P1,14), pw3); \
    l_reg+=sacc; \
    if(GK){DMA_K((t)+3,sl_cur);} if(GV){DMA_V((t)+1,sl_next);} \
    CMASK(C0,C1,t); \
    { float a=MX3(C0[0],C0[1],C1[0]),b=MX3(C0[2],C0[3],C1[1]); a=MX3(a,C1[2],C1[3]); \
      _Pragma("unroll") for(int r=4;r<16;r+=4){a=MX3(a,C0[r],C0[r+1]);b=MX3(b,C0[r+2],C0[r+3]);a=MX3(a,C1[r],C1[r+1]);b=MX3(b,C1[r+2],C1[r+3]);} \
      float rm=__builtin_fmaxf(a,b); { auto rr=__builtin_amdgcn_permlane32_swap(__float_as_uint(rm),__float_as_uint(rm),false,false); rm=__builtin_fmaxf(__uint_as_float(rr[0]),__uint_as_float(rr[1])); } \
      resc=false; bool fresh_=false; if constexpr((MODE&M_WIN)!=0) fresh_=unset&&(rm>-INFINITY); \
      if(__builtin_expect(__any((rm>(float)THRL)||fresh_),0)){ const float dl=fresh_?rm:__builtin_fmaxf(rm,0.f); mhat+=dl; if constexpr((MODE&M_WIN)!=0) unset=unset&&!fresh_; \
        _Pragma("unroll") for(int r=0;r<16;++r){C0[r]-=dl;C1[r]-=dl;} \
        _Pragma("unroll") for(int r=0;r<16;++r)negm[r]=-mhat; asm volatile("":"+v"(negm)); \
        const float f=fresh_?1.f:__builtin_amdgcn_exp2f(-dl); l_reg*=f; if(hi==0)wsf[r32]=f; resc=true; } } \
    SBAR(); \
    GAPB(o[0]=__builtin_amdgcn_mfma_f32_32x32x16_bf16(PAF(0),VFR(0),o[0],0,0,0), C0,0); \
    GAPB(o[1]=__builtin_amdgcn_mfma_f32_32x32x16_bf16(PAF(0),VFR(4),o[1],0,0,0), C0,4); \
    KRD(GL,0); GAPB(o[0]=__builtin_amdgcn_mfma_f32_32x32x16_bf16(PAF(1),VFR(1),o[0],0,0,0), C0,8); \
    KRD(GL,1); GAPB(o[1]=__builtin_amdgcn_mfma_f32_32x32x16_bf16(PAF(1),VFR(5),o[1],0,0,0), C0,12); \
    KRD(GL,2); GAPB(o[0]=__builtin_amdgcn_mfma_f32_32x32x16_bf16(PAF(2),VFR(2),o[0],0,0,0), C1,0); \
    KRD(GL,3); GAPB(o[1]=__builtin_amdgcn_mfma_f32_32x32x16_bf16(PAF(2),VFR(6),o[1],0,0,0), C1,4); \
    GAPB(o[0]=__builtin_amdgcn_mfma_f32_32x32x16_bf16(PAF(3),VFR(3),o[0],0,0,0), C1,8); \
    GAPB(o[1]=__builtin_amdgcn_mfma_f32_32x32x16_bf16(PAF(3),VFR(7),o[1],0,0,0), C1,12); \
    }while(0)
  int t=1;
  #undef CMASK
  #define CMASK(P0,P1,t) KBONLY(P0,P1,t)
  for(;t+7<NT;t+=2){
    STEP(pB0,pB1,pA0,pA1,t,true,true,true);     WAIT_BAR(2); RESC(); ROT();
    STEP(pA0,pA1,pB0,pB1,t+1,true,true,true);   WAIT_BAR(2); RESC(); ROT();
  }
  #undef CMASK
  #define CMASK(P0,P1,t) do{ if constexpr((MODE&M_KB)!=0) kbias(P0,P1,kbl+64*((t)+t_first),hi); fix_tile<MODE>(P0,P1,64*((t)+t_first)-q0,qrel,hi,dtl); }while(0)
  #define ENDW(tt) do{ if((tt)+3<NT){WAIT_BAR(2);} else if((tt)+2<NT){WAIT_BAR(1);} else {WAIT_BAR(0);} }while(0)
  for(;t+1<NT;t+=2){
    STEP(pB0,pB1,pA0,pA1,t,(t+3<NT),(t+1<NT),(t+1<NT));       ENDW(t);   RESC(); ROT();
    STEP(pA0,pA1,pB0,pB1,t+1,(t+4<NT),(t+2<NT),(t+2<NT));     ENDW(t+1); RESC(); ROT();
  }
  STEP(pB0,pB1,pA0,pA1,NT-1,false,false,false); RESC();
  { float sacc=pB0[0]+pB0[1]; _Pragma("unroll") for(int r=2;r<16;++r)sacc+=pB0[r]; _Pragma("unroll") for(int r=0;r<16;++r)sacc+=pB1[r]; l_reg+=sacc;
    pw0=(u32x4){PKW(pB0,0),PKW(pB0,2),PKW(pB0,4),PKW(pB0,6)};pw1=(u32x4){PKW(pB0,8),PKW(pB0,10),PKW(pB0,12),PKW(pB0,14)};pw2=(u32x4){PKW(pB1,0),PKW(pB1,2),PKW(pB1,4),PKW(pB1,6)};pw3=(u32x4){PKW(pB1,8),PKW(pB1,10),PKW(pB1,12),PKW(pB1,14)};
    SBAR(); pv(o,vb0+sl_cur,PAF(0),PAF(1),PAF(2),PAF(3)); }
  #undef PKW
  #undef PAF
  #undef VFR
  #undef PIN
  #undef MX3
  #undef GAPA
  #undef GAPB
  #undef EX
  #undef VRD
  #undef KRD
  #undef STEP
  #undef ENDW
  {auto rr=__builtin_amdgcn_permlane32_swap(__float_as_uint(l_reg),__float_as_uint(l_reg),false,false);l_reg=__uint_as_float(rr[0])+__uint_as_float(rr[1]);}
  if constexpr((MODE&M_WIN)!=0) l_reg+=exp2f(sink2-mhat);
  if(hi==0)wsf[32+r32]=l_reg;asm volatile("s_waitcnt lgkmcnt(0)":::"memory");
  float rli[16];
  #pragma unroll
  for(int r=0;r<16;++r)rli[r]=__builtin_amdgcn_rcpf(wsf[32+crow(r,hi)]);
  bf16*Ow=Og+(long)(q0+wid*QBLK)*opitch;
  { bf16*stg=(bf16*)(shm+LDS_OST)+wid*2048;
    #pragma unroll
    for(int r=0;r<16;++r){const int orow=crow(r,hi);
      #pragma unroll
      for(int d0=0;d0<2;++d0)stg[orow*64+d0*32+r32]=__float2bfloat16(o[d0][r]*rli[r]);}
    asm volatile("s_waitcnt lgkmcnt(0)":::"memory");
    #pragma unroll
    for(int i=0;i<4;++i){const int row=i*8+(lane>>3),ch=lane&7; const u32x4 v=*(const u32x4*)(stg+row*64+ch*8); ATTN_STORE16(Ow+(long)row*opitch+ch*8,v);} }
  asm volatile("s_waitcnt lgkmcnt(0)\n\ts_barrier":::"memory");
  #undef DMA_K
  #undef DMA_V
  #undef CMASK
  #undef KBONLY
  #undef START
  #undef RESC
  #undef ROT
}
constexpr int ATTN_LDS_BYTES=LDS_BYTES;
#undef SBAR
#undef WAIT_BAR
}
#define GAS __attribute__((address_space(1)))
#define LAS __attribute__((address_space(3)))
typedef unsigned short bf16;
typedef unsigned v4u __attribute__((ext_vector_type(4)));
typedef float f32x4 __attribute__((ext_vector_type(4)));
typedef short bf16x8 __attribute__((ext_vector_type(8)));
typedef GAS unsigned gu32;
typedef GAS unsigned long long gu64;
#define RLX_AGENT __ATOMIC_RELAXED, __HIP_MEMORY_SCOPE_AGENT
#define LDS_WAIT() asm volatile("s_waitcnt lgkmcnt(0)" ::: "memory")
#define VM_WAIT() asm volatile("s_waitcnt vmcnt(0)" ::: "memory")
__device__ __forceinline__ unsigned long long rt() { return __builtin_amdgcn_s_memrealtime(); }
__device__ __forceinline__ unsigned f2bf(float f) { unsigned u = __builtin_bit_cast(unsigned, f); return (u + 0x7fffu + ((u >> 16) & 1u)) >> 16; }
__device__ __forceinline__ unsigned pk2(float lo, float hi) { return f2bf(lo) | (f2bf(hi) << 16); }

#define XB_TMO      128
#define XB_XCNT(j)  (256  + 64 * (j))
#define XB_XSUB(j)  (1280 + 64 * (j))
#define XB_XGEN(j)  (2304 + 64 * (j))
#define XB_TOP      3328
#define XB_TOPGEN   3392
#define XCD_BAR_WORDS 3456
#define XB_SPIN_CAP (1u << 18)

__device__ __forceinline__ unsigned xb_ld(unsigned* p)              { return __hip_atomic_load(p, __ATOMIC_RELAXED, __HIP_MEMORY_SCOPE_AGENT); }
__device__ __forceinline__ unsigned xb_add(unsigned* p, unsigned v) { return __hip_atomic_fetch_add(p, v, __ATOMIC_RELAXED, __HIP_MEMORY_SCOPE_AGENT); }
__device__ __forceinline__ unsigned xb_xcc_id() { return (unsigned)__builtin_amdgcn_s_getreg((3 << 11) | 20) & 0xFu; }
#define XB_SPIN(cond, bar) do { unsigned _sp = 0; while (cond) { __builtin_amdgcn_s_sleep(1); \
    if ((++_sp & 255u) == 0u) { if (xb_ld(&(bar)[XB_TMO])) break; if (_sp > XB_SPIN_CAP) { atomicAdd(&(bar)[XB_TMO], 1u); break; } } } } while (0)

struct XcdBarrier {
    unsigned* bar; unsigned x;
    volatile LAS unsigned* st;
};

__device__ __forceinline__ XcdBarrier xcd_barrier_post(unsigned* bar, volatile LAS unsigned* st) {
    XcdBarrier b; b.bar = bar; b.x = xb_xcc_id(); b.st = st;
    if (threadIdx.x == 0) (void)xb_add(&bar[XB_XCNT(b.x)], 1u);
    return b;
}
__device__ __forceinline__ void xcd_barrier_complete(unsigned* bar, unsigned x, unsigned& nloc, unsigned& nx) {
    const unsigned G = gridDim.x * gridDim.y * gridDim.z;
    unsigned sum, cnt, mine, sp = 0u;
    for (;;) {
        sum = 0u; cnt = 0u; mine = 0u;
#pragma unroll
        for (unsigned j = 0; j < 16; ++j) { const unsigned c = xb_ld(&bar[XB_XCNT(j)]); sum += c; cnt += (c > 0u) ? 1u : 0u; mine = (j == x) ? c : mine; }
        if (sum == G) break;
        __builtin_amdgcn_s_sleep(1);
        if ((++sp & 255u) == 0u) { if (xb_ld(&bar[XB_TMO])) break; if (sp > XB_SPIN_CAP) { atomicAdd(&bar[XB_TMO], 1u); break; } }
    }
    nloc = mine > 0u ? mine : 1u; nx = cnt > 0u ? cnt : 1u;
}

__device__ __forceinline__ void xcd_barrier(const XcdBarrier& b) {
    asm volatile("s_waitcnt vmcnt(0)" ::: "memory");
    __syncthreads();
    if (threadIdx.x == 0) {
        unsigned* bar = b.bar;
        __builtin_amdgcn_s_waitcnt(0);
        unsigned nloc = b.st[0], nx = b.st[1];
        if (nloc == 0u) { xcd_barrier_complete(bar, b.x, nloc, nx); b.st[0] = nloc; b.st[1] = nx; }
        const unsigned old = xb_add(&bar[XB_XSUB(b.x)], 1u);
        const unsigned gen = old / nloc;
        if (old + 1u == (gen + 1u) * nloc) {
            __builtin_amdgcn_fence(__ATOMIC_RELEASE, "agent");
            asm volatile("s_waitcnt vmcnt(0)" ::: "memory");
            const unsigned og = xb_add(&bar[XB_TOP], 1u);
            const unsigned tg = og / nx;
            if (og + 1u == (tg + 1u) * nx) xb_add(&bar[XB_TOPGEN], 1u);
            else XB_SPIN(xb_ld(&bar[XB_TOPGEN]) == tg, bar);
            __builtin_amdgcn_fence(__ATOMIC_ACQUIRE, "agent");
            xb_add(&bar[XB_XGEN(b.x)], 1u);
            asm volatile("s_waitcnt vmcnt(0)" ::: "memory");
        } else {
            XB_SPIN(xb_ld(&bar[XB_XGEN(b.x)]) == gen, bar);
            __builtin_amdgcn_fence(__ATOMIC_ACQUIRE, "agent");
            asm volatile("s_waitcnt vmcnt(0)" ::: "memory");
        }
    }
    __syncthreads();
}

constexpr int NWAVES = 8;
constexpr int NB = 4, SEQ = 2048, TOK = NB * SEQ, DM = 2048, NPROJ = 4608, INW = 4360, PLED = 256;
constexpr int NEXP = 16, DEXP = 512, SLOTS = 20480, MAXRT = SLOTS / 256;
constexpr int PC_FQ = 0, PC_FK = 512, PC_FV = 1024, PC_DQ = 1536, PC_DK = 2048, PC_DV = 2560, PC_PU = 3072, PC_SQ = 3584, PC_SK = 4096, PC_SV = 4224, PC_FF = 4352;
constexpr float LOG2E = 1.4426950408889634f;
constexpr float C2 = 0.125f * LOG2E;
constexpr float ALPHA = 1.4142135623730951f;
constexpr float LN_EPS = 1e-5f;
#ifndef SLOWREF_
#define SLOWREF_ 0
#endif
constexpr int NPH = 12;
#ifndef FASTMIX_
#define FASTMIX_ 1
#endif
constexpr bool FASTMIX = FASTMIX_ != 0;
#ifndef FASTMASK_
#define FASTMASK_ 15
#endif
constexpr int FASTMASK = FASTMIX ? FASTMASK_ : 0;

enum { I_X = 0, I_P, I_REL, I_WIN, I_BF, I_LQ1, I_LK1, I_LQ2, I_LK2, I_DNG, I_POOLW, I_POOLS, I_SINK, I_WO, I_LN1G, I_LN1B, I_RGW, I_RGB, I_REW, I_REB, I_WGATE, I_WUP, I_WDOWN, I_PGW, I_PUW, I_LN2G, I_LN2B, N_IN };

constexpr size_t MiB = 1u << 20;
constexpr size_t WS_CTL = 0, CTL_ZERO_BYTES = 1 * MiB;
constexpr size_t WS_KB2 = 1 * MiB;
constexpr size_t WS_TBL = 1 * MiB + 512 * 1024;
constexpr size_t WS_WRT0 = 2 * MiB;
constexpr size_t WS_LTOK = 3 * MiB;
constexpr size_t WS_LW = 3 * MiB + 512 * 1024;
constexpr size_t WS_TOKE = 4 * MiB;
constexpr size_t WS_TOKP = 4 * MiB + 128 * 1024;
constexpr size_t WS_PT0 = 5 * MiB;
constexpr size_t WL = 131 * MiB;
constexpr size_t WS_WIN0 = 6 * MiB, WS_WO0 = 24 * MiB, WS_W10 = 32 * MiB, WS_WD0 = 96 * MiB, WS_WG0 = 128 * MiB, WS_WU0 = 136 * MiB;
constexpr size_t WS_XB = 268 * MiB, WS_PB0 = 300 * MiB;
constexpr size_t WS_A = 308 * MiB;
constexpr size_t WS_U = 388 * MiB;
constexpr size_t WS_C = 420 * MiB;
constexpr size_t WS_DSCR = 452 * MiB;
constexpr size_t WS_PLE = 452 * MiB;
constexpr size_t WS_H = 484 * MiB, WS_HB = 548 * MiB, WS_END = 580 * MiB;
#define WS_WIN (WS_WIN0 + (size_t)l * WL)
#define WS_WO (WS_WO0 + (size_t)l * WL)
#define WS_W1 (WS_W10 + (size_t)l * WL)
#define WS_WD (WS_WD0 + (size_t)l * WL)
#define WS_WG (WS_WG0 + (size_t)l * WL)
#define WS_WU (WS_WU0 + (size_t)l * WL)
#define WS_WRT (WS_WRT0 + (size_t)l * 262144)
#define WS_PT (WS_PT0 + (size_t)l * 131072)
#define WS_PB (WS_PB0 + (size_t)l * 4 * MiB)
constexpr int CW_BAR = 4096;
constexpr int CW_QUE = 12288;
constexpr int CW_CNT = 16384;

constexpr int RING_OFF = 0, RING_BYTES = 131072;
constexpr int LDSCTL_OFF = RING_BYTES, MISC_OFF = LDSCTL_OFF + 320;
constexpr int TAB_OFF = LDSCTL_OFF + 1024;
constexpr int LDS_BYTES = 147456;

static __device__ const unsigned char T5BUCKET[129] = {0, 1, 2, 3, 4, 5, 6, 7, 8, 9, 10, 11, 12, 13, 14, 15, 16, 16, 16, 17, 17, 18, 18, 18, 19, 19, 19, 20, 20, 20, 20, 21, 21, 21, 21, 22, 22, 22, 22, 22, 23, 23, 23, 23, 23, 23, 24, 24, 24, 24, 24, 24, 25, 25, 25, 25, 25, 25, 25, 26, 26, 26, 26, 26, 26, 26, 26, 27, 27, 27, 27, 27, 27, 27, 27, 27, 27, 28, 28, 28, 28, 28, 28, 28, 28, 28, 28, 29, 29, 29, 29, 29, 29, 29, 29, 29, 29, 29, 29, 30, 30, 30, 30, 30, 30, 30, 30, 30, 30, 30, 30, 30, 30, 31, 31, 31, 31, 31, 31, 31, 31, 31, 31, 31, 31, 31, 31, 31, 31};

struct Args { const float* in[N_IN]; float* out; unsigned char* ws; int ph_lo, ph_hi; };

struct Ctx {
    LAS unsigned char* lds; int tid, lane, wave, vcu, G, gw, NGW;
    unsigned char* ws; float* out;
};

__device__ __forceinline__ float wave_sum(float v) {
#pragma unroll
    for (int o = 1; o < 64; o <<= 1) v += __shfl_xor(v, o);
    return v;
}
__device__ __forceinline__ float wave_max(float v) {
#pragma unroll
    for (int o = 1; o < 64; o <<= 1) v = fmaxf(v, __shfl_xor(v, o));
    return v;
}
__device__ __forceinline__ float bf2f(unsigned short b) { return __builtin_bit_cast(float, (unsigned)b << 16); }
__device__ __forceinline__ float bflo(unsigned w) { return __builtin_bit_cast(float, w << 16); }
__device__ __forceinline__ float bfhi(unsigned w) { return __builtin_bit_cast(float, w & 0xffff0000u); }

namespace pg8 {
struct EpiStore {
    static constexpr bool PERM = true, AFTER_DRAIN = false;
    bf16_t* O; int ldc; int pn_mask;
    __device__ __forceinline__ void operator()(const f32x4 (&acc)[2][2][4][2], const Unit& u, int wr, int wc, int fr, int fq) const {
        const int row0 = u.pm * BM + wr * 64 + fr; const int col0 = (u.pn & pn_mask) * BM + wc * 32 + 8 * fq;
#pragma unroll
        for (int ai = 0; ai < 2; ++ai)
#pragma unroll
            for (int m = 0; m < 4; ++m) { bf16_t* rowp = O + (size_t)(row0 + ai * HALF + m * 16) * ldc + col0;
#pragma unroll
                for (int bj = 0; bj < 2; ++bj) { const f32x4 v0 = acc[ai][bj][m][0], v1 = acc[ai][bj][m][1];
                    u32x4 w; w.x = cvt_pk_bf16(v0[0], v0[1]); w.y = cvt_pk_bf16(v0[2], v0[3]); w.z = cvt_pk_bf16(v1[0], v1[1]); w.w = cvt_pk_bf16(v1[2], v1[3]);
                    *(u32x4*)(rowp + bj * HALF) = w; } }
    }
};
struct EpiResF32 {
    static constexpr bool PERM = false, AFTER_DRAIN = false;
    const float* res; float* out; int ldc; float alpha;
    __device__ __forceinline__ void operator()(const f32x4 (&acc)[2][2][4][2], const Unit& u, int wr, int wc, int fr, int fq) const {
        const int col0 = u.pn * BM + wc * 32 + 4 * fq;
#pragma unroll
        for (int ai = 0; ai < 2; ++ai)
#pragma unroll
            for (int m = 0; m < 4; ++m) { const size_t off = (size_t)(u.pm * BM + ai * HALF + wr * 64 + m * 16 + fr) * ldc + col0;
#pragma unroll
                for (int bj = 0; bj < 2; ++bj)
#pragma unroll
                    for (int n = 0; n < 2; ++n) { const f32x4 rs = *(const f32x4*)(res + off + bj * HALF + n * 16); *(f32x4*)(out + off + bj * HALF + n * 16) = acc[ai][bj][m][n] + rs * alpha; } }
    }
};
struct EpiSwiglu {
    static constexpr bool PERM = true, AFTER_DRAIN = false;
    bf16_t* hid; const float* lw; const int* cnt; const __attribute__((address_space(3))) int* ts;
    __device__ __forceinline__ void operator()(const f32x4 (&acc)[2][2][4][2], const Unit& u, int wr, int wc, int fr, int fq) const {
        const int e = u.pn >> 2, j = u.pn & 3; const int pos0 = (u.pm - ts[e]) * BM, ne = cnt[e];
        const int col0 = j * 128 + wc * 32 + 8 * fq;
#pragma unroll
        for (int ai = 0; ai < 2; ++ai)
#pragma unroll
            for (int m = 0; m < 4; ++m) { const int rl = ai * HALF + wr * 64 + m * 16 + fr; const int pos = pos0 + rl;
                const float w = pos < ne ? lw[e * 8192 + pos] : 0.f;
                float r[8];
#pragma unroll
                for (int n = 0; n < 2; ++n)
#pragma unroll
                    for (int i = 0; i < 4; ++i) { const float a = acc[ai][0][m][n][i], up = acc[ai][1][m][n][i]; r[n * 4 + i] = a / (1.f + __expf(-a)) * up * w; }
                u32x4 o; o.x = cvt_pk_bf16(r[0], r[1]); o.y = cvt_pk_bf16(r[2], r[3]); o.z = cvt_pk_bf16(r[4], r[5]); o.w = cvt_pk_bf16(r[6], r[7]);
                *(u32x4*)(hid + (size_t)(u.pm * BM + rl) * 512 + col0) = o; }
    }
};
struct EpiPle {
    static constexpr bool PERM = true, AFTER_DRAIN = false;
    const bf16_t* U; bf16_t* O; int ldc;
    __device__ __forceinline__ void operator()(const f32x4 (&acc)[2][2][4][2], const Unit& u, int wr, int wc, int fr, int fq) const {
        const int row0 = u.pm * BM + wr * 64 + fr; const int col0 = u.pn * BM + wc * 32 + 8 * fq;
#pragma unroll
        for (int ai = 0; ai < 2; ++ai)
#pragma unroll
            for (int m = 0; m < 4; ++m) { const size_t off = (size_t)(row0 + ai * HALF + m * 16) * ldc + col0;
#pragma unroll
                for (int bj = 0; bj < 2; ++bj) { const u32x4 uu = *(const u32x4*)(U + off + bj * HALF); const f32x4 v0 = acc[ai][bj][m][0], v1 = acc[ai][bj][m][1];
                    float r[8];
                    r[0] = __builtin_bit_cast(float, uu.x << 16) / (1.f + __expf(-v0[0])); r[1] = __builtin_bit_cast(float, uu.x & 0xffff0000u) / (1.f + __expf(-v0[1]));
                    r[2] = __builtin_bit_cast(float, uu.y << 16) / (1.f + __expf(-v0[2])); r[3] = __builtin_bit_cast(float, uu.y & 0xffff0000u) / (1.f + __expf(-v0[3]));
                    r[4] = __builtin_bit_cast(float, uu.z << 16) / (1.f + __expf(-v1[0])); r[5] = __builtin_bit_cast(float, uu.z & 0xffff0000u) / (1.f + __expf(-v1[1]));
                    r[6] = __builtin_bit_cast(float, uu.w << 16) / (1.f + __expf(-v1[2])); r[7] = __builtin_bit_cast(float, uu.w & 0xffff0000u) / (1.f + __expf(-v1[3]));
                    u32x4 o; o.x = cvt_pk_bf16(r[0], r[1]); o.y = cvt_pk_bf16(r[2], r[3]); o.z = cvt_pk_bf16(r[4], r[5]); o.w = cvt_pk_bf16(r[6], r[7]);
                    *(u32x4*)(O + off + bj * HALF) = o; } }
    }
};
struct MoeOrder {
    const __attribute__((address_space(3))) int* ts; int ncol, G, c;
    __device__ __forceinline__ bool next(int i, Unit& u) const {
        const int nrt = ts[16]; const int L = i * G + c; if (L >= nrt * ncol) return false;
        const int rt = L / ncol, ct = L - rt * ncol; int e = 0;
#pragma unroll
        for (int j = 1; j < 16; ++j) e += (ts[j] <= rt) ? 1 : 0;
        u.pm = __builtin_amdgcn_readfirstlane(rt); u.pn = __builtin_amdgcn_readfirstlane(e * ncol + ct); return true;
    }
    __device__ __forceinline__ void a_ready(const Unit&) const {}
    __device__ __forceinline__ void done(const Unit&) const {}
};
}

__device__ __forceinline__ void transpose_item(const float* src, int src_ld, int src_col0, int ncols, int k0, bf16* dst, int dst_K, int dst_row0, float scale, LAS float* scr, int lane) {
#pragma unroll 8
    for (int i = 0; i < 32; ++i) { const int kk = 2 * i + (lane >> 5), c = lane & 31;
        float v = 0.f; if (c < ncols) v = src[(size_t)(k0 + kk) * src_ld + src_col0 + c] * scale;
        scr[kk * 33 + c] = v; }
    LDS_WAIT(); asm volatile("" ::: "memory");
    const int c8 = lane & 7;
#pragma unroll
    for (int j = 0; j < 4; ++j) { const int n = (lane >> 3) + 8 * j; const LAS float* s = scr + (8 * c8) * 33 + n;
        v4u o; o.x = pk2(s[0 * 33], s[1 * 33]); o.y = pk2(s[2 * 33], s[3 * 33]); o.z = pk2(s[4 * 33], s[5 * 33]); o.w = pk2(s[6 * 33], s[7 * 33]);
        *(GAS v4u*)(dst + (size_t)(dst_row0 + n) * dst_K + k0 + 8 * c8) = o; }
    LDS_WAIT(); asm volatile("" ::: "memory");
}

__device__ __forceinline__ void ph_prologue_layer(const Ctx& C, const Args& A, int l) {
    LAS float* scr = (LAS float*)(C.lds + RING_OFF + C.wave * 16384);
    unsigned char* ws = C.ws;
    bf16* Win_t = (bf16*)(ws + WS_WIN); bf16* Wo_t = (bf16*)(ws + WS_WO); bf16* W1_t = (bf16*)(ws + WS_W1); bf16* Wd_t = (bf16*)(ws + WS_WD); bf16* Wg_t = (bf16*)(ws + WS_WG); bf16* Wu_t = (bf16*)(ws + WS_WU);
    constexpr int I_WIN_N = 32 * 144, I_WO_N = 32 * 64, I_W1_N = 16 * 32 * 32, I_WD_N = 16 * 8 * 64, I_WG_N = 32 * 64, I_WU_N = 4 * 64, I_PT_N = 32;
    constexpr int NITEMS = I_WIN_N + I_WO_N + I_W1_N + I_WD_N + I_WG_N + I_WU_N + I_PT_N;
    for (int it = C.gw; it < NITEMS; it += C.NGW) {
        int r = it;
        if (r < I_WIN_N) { const int kb = r / 144, db = r % 144, d0 = db * 32; int sc0, nc;
            if (d0 < 1536) { sc0 = d0; nc = 32; } else if (d0 < 4352) { sc0 = d0 + 8; nc = 32; } else if (d0 == 4352) { sc0 = 1536; nc = 8; } else { sc0 = 0; nc = 0; }
            const bool isq = (d0 < 512) || (d0 >= PC_DQ && d0 < PC_DK) || (d0 >= PC_SQ && d0 < PC_SK);
            transpose_item(A.in[I_WIN] + (size_t)l * DM * INW, INW, sc0, nc, kb * 64, Win_t, DM, d0, isq ? C2 : 1.f, scr, C.lane); continue; }
        r -= I_WIN_N;
        if (r < I_WO_N) { const int kb = r / 64, db = r % 64; transpose_item(A.in[I_WO] + (size_t)l * DM * DM, DM, db * 32, 32, kb * 64, Wo_t, DM, db * 32, 1.f, scr, C.lane); continue; }
        r -= I_WO_N;
        if (r < I_W1_N) { const int e = r >> 10, kb = (r >> 5) & 31, db = r & 31; const int j = db >> 3, within = (db & 7) * 32;
            const float* src = (within < 128 ? A.in[I_WGATE] : A.in[I_WUP]) + (size_t)(l * NEXP + e) * DM * DEXP; const int col = 128 * j + (within & 127);
            transpose_item(src, DEXP, col, 32, kb * 64, W1_t + (size_t)e * 1024 * DM, DM, db * 32, 1.f, scr, C.lane); continue; }
        r -= I_W1_N;
        if (r < I_WD_N) { const int e = r >> 9, kb = (r >> 6) & 7, db = r & 63;
            transpose_item(A.in[I_WDOWN] + (size_t)(l * NEXP + e) * DEXP * DM, DM, db * 32, 32, kb * 64, Wd_t + (size_t)e * DM * DEXP, DEXP, db * 32, 1.f, scr, C.lane); continue; }
        r -= I_WD_N;
        if (r < I_WG_N) { const int kb = r / 64, db = r % 64; transpose_item(A.in[I_PGW] + (size_t)l * DM * DM, DM, db * 32, 32, kb * 64, Wg_t, DM, db * 32, 1.f, scr, C.lane); continue; }
        r -= I_WG_N;
        if (r < I_WU_N) { const int kb = r / 64, db = r % 64; transpose_item(A.in[I_PUW] + (size_t)l * PLED * DM, DM, db * 32, 32, kb * 64, Wu_t, PLED, db * 32, 1.f, scr, C.lane); continue; }
        r -= I_WU_N;
        { const int g = r >> 3, kb = (r >> 2) & 1, db = r & 3; transpose_item(A.in[I_POOLW] + (size_t)(l * 4 + g) * 16384, 128, db * 32, 32, kb * 64, (bf16*)(ws + WS_PT) + g * 16384, 128, db * 32, 1.f, scr, C.lane); }
    }
    const int gt = C.vcu * 512 + C.tid, NT = C.G * 512;
    if (l == 0) {
        const GAS f32x4* x4 = (const GAS f32x4*)A.in[I_X]; GAS v4u* o = (GAS v4u*)(ws + WS_XB);
        for (int i = gt; i < TOK * DM / 8; i += NT) { const f32x4 a = x4[2 * i], b = x4[2 * i + 1]; v4u w; w.x = pk2(a.x, a.y); w.y = pk2(a.z, a.w); w.z = pk2(b.x, b.y); w.w = pk2(b.z, b.w); o[i] = w; }
    }
    {
        const GAS f32x4* p4 = (const GAS f32x4*)(A.in[I_P] + (size_t)l * TOK * PLED); GAS v4u* o = (GAS v4u*)(ws + WS_PB);
        for (int i = gt; i < TOK * PLED / 8; i += NT) { const f32x4 a = p4[2 * i], b = p4[2 * i + 1]; v4u w; w.x = pk2(a.x, a.y); w.y = pk2(a.z, a.w); w.z = pk2(b.x, b.y); w.w = pk2(b.z, b.w); o[i] = w; }
    }
    {
        float* tbl = (float*)(ws + WS_TBL);
        for (int i = gt; i < 12 * 129; i += NT) { const int h = i / 129, d = i % 129; tbl[i] = A.in[I_REL][(int)T5BUCKET[d] * 12 + h] * LOG2E; }
        float* wrt = (float*)(ws + WS_WRT);
        for (int i = gt; i < 20 * DM; i += NT) { const int j = i / DM, k = i % DM; wrt[i] = j < 4 ? A.in[I_RGW][((size_t)l * DM + k) * 4 + j] : A.in[I_REW][((size_t)l * DM + k) * 16 + (j - 4)]; }
    }
}

#if SLOWREF_
__device__ __forceinline__ float slow_attn_row(const bf16* proj, int qcol, int kcol, int vcol, int b, int t, int window, const float* kb2, const float* dt, bool has_sink, float sink2, int lane) {
    const bf16* base = proj + (size_t)b * SEQ * NPROJ;
    float q[64];
    { const v4u* qp = (const v4u*)(base + (size_t)t * NPROJ + qcol);
#pragma unroll
      for (int i = 0; i < 8; ++i) { const v4u w = qp[i]; q[8 * i + 0] = bflo(w.x); q[8 * i + 1] = bfhi(w.x); q[8 * i + 2] = bflo(w.y); q[8 * i + 3] = bfhi(w.y); q[8 * i + 4] = bflo(w.z); q[8 * i + 5] = bfhi(w.z); q[8 * i + 6] = bflo(w.w); q[8 * i + 7] = bfhi(w.w); } }
    const int lo = window ? (t - window + 1 > 0 ? t - window + 1 : 0) : 0;
    float mx = -INFINITY;
    for (int s = lo + lane; s <= t; s += 64) {
        const v4u* kp = (const v4u*)(base + (size_t)s * NPROJ + kcol); float d = 0.f;
#pragma unroll
        for (int i = 0; i < 8; ++i) { const v4u w = kp[i]; d += q[8 * i + 0] * bflo(w.x) + q[8 * i + 1] * bfhi(w.x) + q[8 * i + 2] * bflo(w.y) + q[8 * i + 3] * bfhi(w.y) + q[8 * i + 4] * bflo(w.z) + q[8 * i + 5] * bfhi(w.z) + q[8 * i + 6] * bflo(w.w) + q[8 * i + 7] * bfhi(w.w); }
        if (kb2) d += kb2[s];
        if (dt) { const int dd = t - s; d += dt[dd < 128 ? dd : 128]; }
        mx = fmaxf(mx, d);
    }
    mx = wave_max(mx); if (has_sink) mx = fmaxf(mx, sink2);
    float l = 0.f; float o[64];
#pragma unroll
    for (int i = 0; i < 64; ++i) o[i] = 0.f;
    for (int s = lo + lane; s <= t; s += 64) {
        const v4u* kp = (const v4u*)(base + (size_t)s * NPROJ + kcol); float d = 0.f;
#pragma unroll
        for (int i = 0; i < 8; ++i) { const v4u w = kp[i]; d += q[8 * i + 0] * bflo(w.x) + q[8 * i + 1] * bfhi(w.x) + q[8 * i + 2] * bflo(w.y) + q[8 * i + 3] * bfhi(w.y) + q[8 * i + 4] * bflo(w.z) + q[8 * i + 5] * bfhi(w.z) + q[8 * i + 6] * bflo(w.w) + q[8 * i + 7] * bfhi(w.w); }
        if (kb2) d += kb2[s];
        if (dt) { const int dd = t - s; d += dt[dd < 128 ? dd : 128]; }
        const float p = exp2f(d - mx); l += p;
        const v4u* vp = (const v4u*)(base + (size_t)s * NPROJ + vcol);
#pragma unroll
        for (int i = 0; i < 8; ++i) { const v4u w = vp[i]; o[8 * i + 0] += p * bflo(w.x); o[8 * i + 1] += p * bfhi(w.x); o[8 * i + 2] += p * bflo(w.y); o[8 * i + 3] += p * bfhi(w.y); o[8 * i + 4] += p * bflo(w.z); o[8 * i + 5] += p * bfhi(w.z); o[8 * i + 6] += p * bflo(w.w); o[8 * i + 7] += p * bfhi(w.w); }
    }
    l = wave_sum(l); if (has_sink) l += exp2f(sink2 - mx);
#pragma unroll
    for (int st = 0; st < 6; ++st) { const int off = 32 >> st, n = 32 >> st; const bool up = (lane & off) != 0;
#pragma unroll
        for (int i = 0; i < n; ++i) { const float a = o[i], bb = o[i + n]; const float keep = up ? bb : a, send = up ? a : bb; o[i] = keep + __shfl_xor(send, off); } }
    return o[0] / l;
}

__device__ __forceinline__ void ph_mix_a(const Ctx& C, const Args& A, int l) {
    unsigned char* ws = C.ws; const bf16* proj = (const bf16*)(ws + WS_A); bf16* mix = (bf16*)(ws + WS_C); float* dscr = (float*)(ws + WS_DSCR);
    float* kb2 = (float*)(ws + WS_KB2); const float* tbl = (const float*)(ws + WS_TBL);
    const int lane = C.lane;
    if (!(FASTMASK & 1)) for (int u = C.gw; u < NB * 8; u += C.NGW) { const int b = u >> 3, h = u & 7; const float bf = A.in[I_BF][l * 8 + h];
        float v[32]; float run = 0.f;
#pragma unroll
        for (int i = 0; i < 32; ++i) { const int s = lane * 32 + i; const float f = bf2f(proj[(size_t)(b * SEQ + s) * NPROJ + PC_FF + h]) + bf;
            const float ls = fminf(f, 0.f) - log1pf(expf(-fabsf(f))); run += ls; v[i] = run; }
        float inc = run;
#pragma unroll
        for (int o = 1; o < 64; o <<= 1) { const float t = __shfl_up(inc, o); if (lane >= o) inc += t; }
        const float excl = inc - run;
#pragma unroll
        for (int i = 0; i < 32; ++i) kb2[(size_t)u * SEQ + lane * 32 + i] = -(excl + v[i]) * LOG2E;
    }
    if (!(FASTMASK & 8)) { LAS float* pw = (LAS float*)(C.lds + RING_OFF + C.wave * 16384);
      const float* W = A.in[I_POOLW] + (size_t)l * 4 * 128 * 128; const float* sc = A.in[I_POOLS] + l * 512;
      for (int t = C.gw; t < TOK; t += C.NGW) { const int tt = t & (SEQ - 1);
#pragma unroll
        for (int i = 0; i < 8; ++i) { const int c = lane + 64 * i, g = c >> 7, w = 2 << g; const int n = tt + 1 < w ? tt + 1 : w; float s = 0.f;
            for (int k = 0; k < n; ++k) s += bf2f(proj[(size_t)(t - k) * NPROJ + PC_PU + c]);
            pw[c] = s / (float)n - bf2f(proj[(size_t)t * NPROJ + PC_PU + c]); }
        LDS_WAIT(); asm volatile("" ::: "memory");
#pragma unroll
        for (int g = 0; g < 4; ++g) { float a0 = 0.f, a1 = 0.f; const float* Wg = W + g * 128 * 128;
            for (int c = 0; c < 128; ++c) { const float pv = pw[g * 128 + c]; a0 += pv * Wg[c * 128 + lane]; a1 += pv * Wg[c * 128 + lane + 64]; }
            mix[(size_t)t * DM + 1024 + g * 128 + lane] = (bf16)f2bf(a0 * sc[g * 128 + lane]); mix[(size_t)t * DM + 1024 + g * 128 + lane + 64] = (bf16)f2bf(a1 * sc[g * 128 + lane + 64]); }
        LDS_WAIT(); asm volatile("" ::: "memory");
      } }
    if (!(FASTMASK & 4)) for (int u = C.gw; u < 8 * TOK; u += C.NGW) { const int h = u / TOK, t = u % TOK, b = t / SEQ, tt = t % SEQ;
        const float r = slow_attn_row(proj, PC_SQ + h * 64, PC_SK + (h >> 2) * 64, PC_SV + (h >> 2) * 64, b, tt, 128, nullptr, tbl + (4 + h) * 129, true, A.in[I_SINK][l * 8 + h] * LOG2E, lane);
        mix[(size_t)t * DM + 1536 + h * 64 + lane] = (bf16)f2bf(r); }
    if (!(FASTMASK & 2)) for (int u = C.gw; u < 16 * TOK; u += C.NGW) { const int hh = u / TOK, t = u % TOK, b = t / SEQ, tt = t % SEQ; const int h = hh >> 2, m = (hh >> 1) & 1, half = hh & 1;
        const float r = slow_attn_row(proj, PC_DQ + (h * 2 + m) * 64, PC_DK + (h * 2 + m) * 64, PC_DV + h * 128 + half * 64, b, tt, 0, nullptr, tbl + h * 129, false, 0.f, lane);
        dscr[((size_t)t * 2 + m) * 512 + h * 128 + half * 64 + lane] = r; }
}
__device__ __forceinline__ void ph_mix_b(const Ctx& C, const Args& A, int l) {
    unsigned char* ws = C.ws; const bf16* proj = (const bf16*)(ws + WS_A); bf16* mix = (bf16*)(ws + WS_C); const float* dscr = (const float*)(ws + WS_DSCR);
    const float* kb2 = (const float*)(ws + WS_KB2); const int lane = C.lane;
    if (!(FASTMASK & 1)) for (int u = C.gw; u < 8 * TOK; u += C.NGW) { const int h = u / TOK, t = u % TOK, b = t / SEQ, tt = t % SEQ;
        const float r = slow_attn_row(proj, PC_FQ + h * 64, PC_FK + h * 64, PC_FV + h * 64, b, tt, 0, kb2 + (size_t)(b * 8 + h) * SEQ, nullptr, false, 0.f, lane);
        mix[(size_t)t * DM + h * 64 + lane] = (bf16)f2bf(r); }
    const float lam_init = (l == 0) ? 0.2f : 0.35550907f;
    const float s1 = wave_sum(A.in[I_LQ1][l * 64 + lane] * A.in[I_LK1][l * 64 + lane]), s2 = wave_sum(A.in[I_LQ2][l * 64 + lane] * A.in[I_LK2][l * 64 + lane]);
    const float lam = expf(s1) - expf(s2) + lam_init;
    const float g0 = A.in[I_DNG][l * 128 + lane], g1 = A.in[I_DNG][l * 128 + 64 + lane];
    if (!(FASTMASK & 2)) for (int u = C.gw; u < 4 * TOK; u += C.NGW) { const int h = u & 3, t = u >> 2;
        const float* o0 = dscr + ((size_t)t * 2 + 0) * 512 + h * 128; const float* o1 = dscr + ((size_t)t * 2 + 1) * 512 + h * 128;
        const float d0 = o0[lane] - lam * o1[lane], d1 = o0[lane + 64] - lam * o1[lane + 64];
        const float ms = wave_sum(d0 * d0 + d1 * d1) * (1.f / 128.f); const float r = 1.f / sqrtf(ms + LN_EPS) * (1.f - lam_init);
        mix[(size_t)t * DM + 512 + h * 128 + lane] = (bf16)f2bf(d0 * r * g0); mix[(size_t)t * DM + 512 + h * 128 + 64 + lane] = (bf16)f2bf(d1 * r * g1); }
}


#endif
constexpr int MX_KBL = 86016, MX_DTL = 94208, MX_WSUM = 95232;
constexpr int MX_NUNITS = 768 + 256 + 128;
__device__ __forceinline__ void fox_scan(const Ctx& C, const bf16* proj, int b, int h, int n, float bfv) {
    LAS float* kbl = (LAS float*)(C.lds + MX_KBL); LAS float* wsum = (LAS float*)(C.lds + MX_WSUM);
    const int s0 = 4 * C.tid; const bool act = s0 < n; float c[4]; float run = 0.f;
#pragma unroll
    for (int k = 0; k < 4; ++k) { float ls = 0.f; if (act) { const float f = bf2f(proj[(size_t)(b * SEQ + s0 + k) * NPROJ + PC_FF + h]) + bfv; ls = fminf(f, 0.f) - __logf(1.f + __expf(-fabsf(f))); } run += ls; c[k] = run; }
    float inc = run;
#pragma unroll
    for (int o = 1; o < 64; o <<= 1) { const float t = __shfl_up(inc, o); if (C.lane >= o) inc += t; }
    const float excl = inc - run;
    if (C.lane == 63) wsum[C.wave] = inc;
    __syncthreads();
    float pre = 0.f;
#pragma unroll
    for (int w = 0; w < 8; ++w) pre += (w < C.wave) ? wsum[w] : 0.f;
    if (act) {
#pragma unroll
        for (int k = 0; k < 4; ++k) kbl[s0 + k] = -(pre + excl + c[k]) * LOG2E; }
    __syncthreads();
}
template <int G> __device__ __forceinline__ void pool_unit(const Ctx& C, const Args& A, int l, int blk) {
    constexpr int W = 2 << G;
    const bf16* proj = (const bf16*)(C.ws + WS_A); bf16* mix = (bf16*)(C.ws + WS_C); const bf16* pt = (const bf16*)(C.ws + WS_PT) + G * 16384;
    LAS unsigned char* Wt = C.lds; LAS unsigned char* At = C.lds + 36864 + C.wave * 8704;
    const int tid = C.tid, lane = C.lane;
#pragma unroll
    for (int i = 0; i < 4; ++i) { const int ch = tid + 512 * i, row = ch >> 4, cc = ch & 15; *(LAS v4u*)(Wt + row * 272 + cc * 16) = *(const GAS v4u*)(pt + row * 128 + cc * 8); }
    const int t0 = blk * 256 + C.wave * 32, tt0 = t0 & (SEQ - 1); const int col = PC_PU + G * 128 + 2 * lane;
    float Pa[49], Pb[49]; Pa[0] = 0.f; Pb[0] = 0.f;
#pragma unroll
    for (int k = 0; k < 48; ++k) { const int j = k - 16; float ua = 0.f, ub = 0.f;
        if (tt0 + j >= 0) { const unsigned w = *(const GAS unsigned*)(proj + (size_t)(t0 + j) * NPROJ + col); ua = bflo(w); ub = bfhi(w); }
        Pa[k + 1] = Pa[k] + ua; Pb[k + 1] = Pb[k] + ub; }
#pragma unroll
    for (int j = 0; j < 32; ++j) { const int tt = tt0 + j; const float cn = (float)(tt + 1 < W ? tt + 1 : W);
        const float pa = (Pa[j + 17] - Pa[j + 17 - W]) / cn - (Pa[j + 17] - Pa[j + 16]), pb = (Pb[j + 17] - Pb[j + 17 - W]) / cn - (Pb[j + 17] - Pb[j + 16]);
        *(LAS unsigned*)(At + j * 272 + lane * 4) = pk2(pa, pb); }
    __syncthreads();
    typedef float f32x16 __attribute__((ext_vector_type(16)));
    f32x16 acc[4];
#pragma unroll
    for (int nb = 0; nb < 4; ++nb) acc[nb] = f32x16{};
    const int r32 = lane & 31, hi = lane >> 5;
#pragma unroll
    for (int ks = 0; ks < 8; ++ks) { const bf16x8 a = *(const LAS bf16x8*)(At + r32 * 272 + (16 * ks + 8 * hi) * 2);
#pragma unroll
        for (int nb = 0; nb < 4; ++nb) { const bf16x8 bb = *(const LAS bf16x8*)(Wt + (32 * nb + r32) * 272 + (16 * ks + 8 * hi) * 2); acc[nb] = __builtin_amdgcn_mfma_f32_32x32x16_bf16(a, bb, acc[nb], 0, 0, 0); } }
    const float* sc = A.in[I_POOLS] + l * 512 + G * 128;
#pragma unroll
    for (int nb = 0; nb < 4; ++nb) { const float s = sc[32 * nb + r32];
#pragma unroll
        for (int r = 0; r < 16; ++r) { const int row = (r & 3) + 8 * (r >> 2) + 4 * hi; mix[(size_t)(t0 + row) * DM + 1024 + G * 128 + 32 * nb + r32] = (bf16)f2bf(acc[nb][r] * s); } }
    __syncthreads();
}
__device__ __forceinline__ void ph_mixer(const Ctx& C0, const Args& A, int l, char* lds_generic) {
    unsigned char* ws = C0.ws; const bf16* proj = (const bf16*)(ws + WS_A); bf16* mix = (bf16*)(ws + WS_C); bf16* dscr = (bf16*)(ws + WS_DSCR);
    const float* tbl = (const float*)(ws + WS_TBL); unsigned* que = (unsigned*)(ws + WS_CTL) + CW_QUE + 64 * l;
    volatile LAS unsigned* qw = (volatile LAS unsigned*)(C0.lds + TAB_OFF + 128);
    LAS float* dtl = (LAS float*)(C0.lds + MX_DTL);
    const attn_body::lds_fptr kblp = (attn_body::lds_fptr)(C0.lds + MX_KBL), dtlp = (attn_body::lds_fptr)(C0.lds + MX_DTL);
    typedef attn_body::bf16 abf;
    for (;;) {
        Ctx C = C0; { int t_ = threadIdx.x; asm volatile("" : "+v"(t_)); C.tid = t_; C.lane = t_ & 63; C.wave = __builtin_amdgcn_readfirstlane(t_ >> 6); }
        __syncthreads();
        if (C.tid == 0) qw[0] = atomicAdd(que, 1u);
        __syncthreads();
        const int idx = (int)__builtin_amdgcn_readfirstlane(qw[0]);
        if (idx >= MX_NUNITS) break;
        if (idx < 768) { const int qb = 7 - idx / 96, rem = idx % 96;
            if (rem < 32) { if (FASTMASK & 1) { const int b = rem >> 3, h = rem & 7;
                fox_scan(C, proj, b, h, qb * 256 + 256, A.in[I_BF][l * 8 + h]);
                const bf16* pb_ = proj + (size_t)b * SEQ * NPROJ;
                attn_body::attn_unit<attn_body::M_KB, 8>((const abf*)(pb_ + PC_FQ + h * 64), (const abf*)(pb_ + PC_FK + h * 64), (const abf*)(pb_ + PC_FV + h * 64), (abf*)(mix + (size_t)b * SEQ * DM + h * 64), DM, qb * 256, 0, 4 * qb + 4, kblp, dtlp, 0.f, lds_generic); }
            } else if (FASTMASK & 2) { const int r2 = rem - 32, b = r2 >> 4, hh = r2 & 15, h = hh >> 2, m = (hh >> 1) & 1, half = hh & 1;
                if (C.tid < 129) dtl[C.tid] = tbl[h * 129 + C.tid] - tbl[h * 129 + 128];
                __syncthreads();
                const bf16* pb_ = proj + (size_t)b * SEQ * NPROJ;
                attn_body::attn_unit<attn_body::M_DIST, 8>((const abf*)(pb_ + PC_DQ + (h * 2 + m) * 64), (const abf*)(pb_ + PC_DK + (h * 2 + m) * 64), (const abf*)(pb_ + PC_DV + h * 128 + half * 64), (abf*)(dscr + (size_t)b * SEQ * 1024 + m * 512 + h * 128 + half * 64), 1024, qb * 256, 0, 4 * qb + 4, kblp, dtlp, 0.f, lds_generic);
            }
        } else if (idx < 1024) { if (FASTMASK & 4) { const int r = idx - 768, qb = 7 - (r >> 5), b = (r & 31) >> 3, h = r & 7;
            if (C.tid < 129) dtl[C.tid] = tbl[(4 + h) * 129 + C.tid];
            __syncthreads();
            const bf16* pb_ = proj + (size_t)b * SEQ * NPROJ;
            attn_body::attn_unit<attn_body::M_DIST | attn_body::M_WIN, 8>((const abf*)(pb_ + PC_SQ + h * 64), (const abf*)(pb_ + PC_SK + (h >> 2) * 64), (const abf*)(pb_ + PC_SV + (h >> 2) * 64), (abf*)(mix + (size_t)b * SEQ * DM + 1536 + h * 64), DM, qb * 256, qb ? 4 * qb - 2 : 0, qb ? 6 : 4, kblp, dtlp, A.in[I_SINK][l * 8 + h] * LOG2E, lds_generic); }
        } else if (FASTMASK & 8) { const int r = idx - 1024, blk = r >> 2, g = r & 3;
            if (g == 0) pool_unit<0>(C, A, l, blk); else if (g == 1) pool_unit<1>(C, A, l, blk); else if (g == 2) pool_unit<2>(C, A, l, blk); else pool_unit<3>(C, A, l, blk);
        }
    }
}
__device__ __forceinline__ void ph_combine(const Ctx& C, const Args& A, int l) {
    unsigned char* ws = C.ws; bf16* mix = (bf16*)(ws + WS_C); const bf16* dscr = (const bf16*)(ws + WS_DSCR); const int lane = C.lane;
    const float lam_init = (l == 0) ? 0.2f : 0.35550907f;
    const float s1 = wave_sum(A.in[I_LQ1][l * 64 + lane] * A.in[I_LK1][l * 64 + lane]), s2 = wave_sum(A.in[I_LQ2][l * 64 + lane] * A.in[I_LK2][l * 64 + lane]);
    const float lam = expf(s1) - expf(s2) + lam_init;
    const float g0 = A.in[I_DNG][l * 128 + 2 * lane], g1 = A.in[I_DNG][l * 128 + 2 * lane + 1];
    if (FASTMASK & 2) for (int u = C.gw; u < 4 * TOK; u += C.NGW) { const int h = u & 3, t = u >> 2;
        const unsigned a = *(const GAS unsigned*)(dscr + (size_t)t * 1024 + h * 128 + 2 * lane), b = *(const GAS unsigned*)(dscr + (size_t)t * 1024 + 512 + h * 128 + 2 * lane);
        const float d0 = bflo(a) - lam * bflo(b), d1 = bfhi(a) - lam * bfhi(b);
        const float ms = wave_sum(d0 * d0 + d1 * d1) * (1.f / 128.f); const float r = 1.f / sqrtf(ms + LN_EPS) * (1.f - lam_init);
        *(GAS unsigned*)(mix + (size_t)t * DM + 512 + h * 128 + 2 * lane) = pk2(d0 * r * g0, d1 * r * g1); }
}

__device__ __forceinline__ void ph_ln1_router(const Ctx& C, const Args& A, int l) {
    unsigned char* ws = C.ws; const float* z = (const float*)(ws + WS_A); float* hf = (float*)(ws + WS_H); bf16* hb = (bf16*)(ws + WS_HB);
    const float* wrt = (const float*)(ws + WS_WRT); unsigned* cnt = (unsigned*)(ws + WS_CTL) + CW_CNT + 64 * l;
    int* ltok = (int*)(ws + WS_LTOK); float* lw = (float*)(ws + WS_LW); int* toke = (int*)(ws + WS_TOKE); int* tokp = (int*)(ws + WS_TOKP);
    const int lane = C.lane; const float* g = A.in[I_LN1G] + l * DM; const float* bb = A.in[I_LN1B] + l * DM;
    for (int t = C.gw; t < TOK; t += C.NGW) {
        const GAS f32x4* zr = (const GAS f32x4*)(z + (size_t)t * DM) + lane; f32x4 v[8]; float s = 0.f;
#pragma unroll
        for (int j = 0; j < 8; ++j) { v[j] = zr[64 * j]; s += (v[j].x + v[j].y) + (v[j].z + v[j].w); }
        const float mean = wave_sum(s) * (1.f / DM); float s2 = 0.f;
#pragma unroll
        for (int j = 0; j < 8; ++j) { v[j] = v[j] - mean; s2 += (v[j].x * v[j].x + v[j].y * v[j].y) + (v[j].z * v[j].z + v[j].w * v[j].w); }
        const float rstd = 1.f / sqrtf(wave_sum(s2) * (1.f / DM) + LN_EPS);
#pragma unroll
        for (int j = 0; j < 8; ++j) { const f32x4 gg = *((const f32x4*)g + lane + 64 * j), bv = *((const f32x4*)bb + lane + 64 * j); v[j] = v[j] * rstd * gg + bv;
            *((GAS f32x4*)(hf + (size_t)t * DM) + lane + 64 * j) = v[j];
            *((GAS unsigned long long*)(hb + (size_t)t * DM) + lane + 64 * j) = (unsigned long long)pk2(v[j].x, v[j].y) | ((unsigned long long)pk2(v[j].z, v[j].w) << 32); }
        float mylg = 0.f;
#pragma unroll 1
        for (int e = 0; e < 20; ++e) { float a = 0.f;
#pragma unroll
            for (int j = 0; j < 8; ++j) { const f32x4 w = *((const f32x4*)(wrt + e * DM) + lane + 64 * j); a += (v[j].x * w.x + v[j].y * w.y) + (v[j].z * w.z + v[j].w * w.w); }
            a = wave_sum(a); if (lane == e) mylg = a; }
        {
            const float* rgb = A.in[I_RGB] + l * 4; const float* reb = A.in[I_REB] + l * 16;
            const float q0 = __shfl(mylg, 0) + rgb[0], q1 = __shfl(mylg, 1) + rgb[1], q2 = __shfl(mylg, 2) + rgb[2], q3 = __shfl(mylg, 3) + rgb[3];
            int gs = 0; float gm = q0;
            if (q1 > gm) { gm = q1; gs = 1; }
            if (q2 > gm) { gm = q2; gs = 2; }
            if (q3 > gm) { gm = q3; gs = 3; }
            const float gp = 1.f / (expf(q0 - gm) + expf(q1 - gm) + expf(q2 - gm) + expf(q3 - gm));
            const float c0 = __shfl(mylg, 4 + gs * 4 + 0) + reb[gs * 4 + 0], c1 = __shfl(mylg, 4 + gs * 4 + 1) + reb[gs * 4 + 1], c2 = __shfl(mylg, 4 + gs * 4 + 2) + reb[gs * 4 + 2], c3 = __shfl(mylg, 4 + gs * 4 + 3) + reb[gs * 4 + 3];
            int i1 = 0; float v1 = c0;
            if (c1 > v1) { v1 = c1; i1 = 1; }
            if (c2 > v1) { v1 = c2; i1 = 2; }
            if (c3 > v1) { v1 = c3; i1 = 3; }
            int i2 = -1; float v2 = -INFINITY;
            if (i1 != 0 && c0 > v2) { v2 = c0; i2 = 0; }
            if (i1 != 1 && c1 > v2) { v2 = c1; i2 = 1; }
            if (i1 != 2 && c2 > v2) { v2 = c2; i2 = 2; }
            if (i1 != 3 && c3 > v2) { v2 = c3; i2 = 3; }
            const float ex = expf(v2 - v1); const float w1 = gp / (1.f + ex), w2 = gp * ex / (1.f + ex);
            const int e1 = gs * 4 + i1, e2 = gs * 4 + i2;
            if (lane == 0) {
            const unsigned p1 = atomicAdd(cnt + e1, 1u), p2 = atomicAdd(cnt + e2, 1u);
            ltok[e1 * 8192 + p1] = t; lw[e1 * 8192 + p1] = w1; ltok[e2 * 8192 + p2] = t; lw[e2 * 8192 + p2] = w2;
            toke[t * 2] = e1; toke[t * 2 + 1] = e2; tokp[t * 2] = (int)p1; tokp[t * 2 + 1] = (int)p2;
            }
        }
    }
}
__device__ __forceinline__ void build_ts(const Ctx& C, int l) {
    LAS int* ts = (LAS int*)(C.lds + TAB_OFF); const unsigned* cnt = (const unsigned*)(C.ws + WS_CTL) + CW_CNT + 64 * l;
    __syncthreads();
    if (C.tid == 0) { int acc = 0; for (int e = 0; e < 16; ++e) { ts[e] = acc; acc += ((int)__hip_atomic_load(cnt + e, __ATOMIC_RELAXED, __HIP_MEMORY_SCOPE_AGENT) + 255) >> 8; } ts[16] = acc; }
    __syncthreads();
}
__device__ __forceinline__ void ph_gather(const Ctx& C, const Args& A, int l) {
    build_ts(C, l);
    const LAS int* ts = (const LAS int*)(C.lds + TAB_OFF); const unsigned* cnt = (const unsigned*)(C.ws + WS_CTL) + CW_CNT + 64 * l;
    const int* ltok = (const int*)(C.ws + WS_LTOK); const bf16* hb = (const bf16*)(C.ws + WS_HB); bf16* hp = (bf16*)(C.ws + WS_A);
    const int nslot = ts[16] * 256;
    for (int s = C.gw; s < nslot; s += C.NGW) { const int rt = s >> 8; int e = 0;
#pragma unroll
        for (int j = 1; j < 16; ++j) e += (ts[j] <= rt) ? 1 : 0;
        const int pos = s - ts[e] * 256; GAS v4u* d = (GAS v4u*)(hp + (size_t)s * DM) + C.lane;
        if (pos < (int)cnt[e]) { const int t = ltok[e * 8192 + pos]; const GAS v4u* sp = (const GAS v4u*)(hb + (size_t)t * DM) + C.lane;
#pragma unroll
            for (int j = 0; j < 4; ++j) d[64 * j] = sp[64 * j]; }
        else {
#pragma unroll
            for (int j = 0; j < 4; ++j) d[64 * j] = (v4u){0u, 0u, 0u, 0u}; }
    }
}
__device__ __forceinline__ void ph_ln2(const Ctx& C, const Args& A, int l) {
    build_ts(C, l);
    const LAS int* ts = (const LAS int*)(C.lds + TAB_OFF);
    unsigned char* ws = C.ws; const float* hf = (const float*)(ws + WS_H); const bf16* ys = (const bf16*)(ws + WS_A); const bf16* ple = (const bf16*)(ws + WS_PLE);
    const int* toke = (const int*)(ws + WS_TOKE); const int* tokp = (const int*)(ws + WS_TOKP); bf16* xb = (bf16*)(ws + WS_XB);
    const int lane = C.lane; const float* g = A.in[I_LN2G] + l * DM; const float* bb = A.in[I_LN2B] + l * DM;
    for (int t = C.gw; t < TOK; t += C.NGW) {
        const int e1 = toke[t * 2], e2 = toke[t * 2 + 1]; const int s1 = ts[e1] * 256 + tokp[t * 2], s2 = ts[e2] * 256 + tokp[t * 2 + 1];
        f32x4 v[8]; float s = 0.f;
#pragma unroll
        for (int j = 0; j < 8; ++j) { const f32x4 hv = *((const GAS f32x4*)(hf + (size_t)t * DM) + lane + 64 * j);
            const unsigned long long a = *((const GAS unsigned long long*)(ys + (size_t)s1 * DM) + lane + 64 * j), b = *((const GAS unsigned long long*)(ys + (size_t)s2 * DM) + lane + 64 * j), c = *((const GAS unsigned long long*)(ple + (size_t)t * DM) + lane + 64 * j);
            const unsigned a0 = (unsigned)a, a1 = (unsigned)(a >> 32), b0 = (unsigned)b, b1 = (unsigned)(b >> 32), c0 = (unsigned)c, c1 = (unsigned)(c >> 32);
            v[j].x = ALPHA * hv.x + (bflo(a0) + bflo(b0)) + bflo(c0); v[j].y = ALPHA * hv.y + (bfhi(a0) + bfhi(b0)) + bfhi(c0);
            v[j].z = ALPHA * hv.z + (bflo(a1) + bflo(b1)) + bflo(c1); v[j].w = ALPHA * hv.w + (bfhi(a1) + bfhi(b1)) + bfhi(c1);
            s += (v[j].x + v[j].y) + (v[j].z + v[j].w); }
        const float mean = wave_sum(s) * (1.f / DM); float q = 0.f;
#pragma unroll
        for (int j = 0; j < 8; ++j) { v[j] = v[j] - mean; q += (v[j].x * v[j].x + v[j].y * v[j].y) + (v[j].z * v[j].z + v[j].w * v[j].w); }
        const float rstd = 1.f / sqrtf(wave_sum(q) * (1.f / DM) + LN_EPS);
#pragma unroll
        for (int j = 0; j < 8; ++j) { const f32x4 gg = *((const f32x4*)g + lane + 64 * j), bv = *((const f32x4*)bb + lane + 64 * j); v[j] = v[j] * rstd * gg + bv;
            *((GAS f32x4*)(C.out + (size_t)t * DM) + lane + 64 * j) = v[j];
            if (l == 0) *((GAS unsigned long long*)(xb + (size_t)t * DM) + lane + 64 * j) = (unsigned long long)pk2(v[j].x, v[j].y) | ((unsigned long long)pk2(v[j].z, v[j].w) << 32); }
    }
}

constexpr int NPHASE = 1 + 2 * 9;
#ifndef MK_PER_PHASE
#define MK_PER_PHASE 0
#endif
__global__ void __launch_bounds__(NWAVES * 64, 2) mk_fwd(Args args) {
    extern __shared__ __attribute__((aligned(16))) unsigned char lds_raw[];
    Ctx C;
    C.lds = (LAS unsigned char*)lds_raw;
    C.G = gridDim.x; { const int bx = blockIdx.x; C.vcu = (C.G % 8 == 0) ? (bx % 8) * (C.G / 8) + bx / 8 : bx; }
    C.NGW = C.G * NWAVES; C.ws = args.ws; C.out = args.out;
    { const int t0 = threadIdx.x; for (int u = t0; u < (LDS_BYTES - LDSCTL_OFF) / 4; u += NWAVES * 64) ((LAS unsigned*)(C.lds + LDSCTL_OFF))[u] = 0u; }
    __syncthreads();
    const bool multi = (args.ph_hi - args.ph_lo) > 1;
    XcdBarrier bar; bar.bar = (unsigned*)(args.ws + WS_CTL) + CW_BAR; bar.x = 0; bar.st = nullptr;
    if (multi) bar = xcd_barrier_post((unsigned*)(args.ws + WS_CTL) + CW_BAR, (volatile LAS unsigned*)(C.lds + MISC_OFF) + 8);

    for (int ph = args.ph_lo; ph < args.ph_hi; ++ph) {
        { int t_ = threadIdx.x; asm volatile("" : "+v"(t_)); C.tid = t_; C.lane = t_ & 63; C.wave = __builtin_amdgcn_readfirstlane(t_ >> 6); C.gw = C.vcu * NWAVES + C.wave; }
        unsigned char* ws = args.ws; asm volatile("" : "+s"(ws)); C.ws = ws;
        const int l = ph == 0 ? 0 : (ph - 1) / 9, k = ph == 0 ? -1 : (ph - 1) % 9;
        if (k == -1) { ph_prologue_layer(C, args, 0); ph_prologue_layer(C, args, 1); }
        else if (k == 0) {
            for (int sub = 0; sub < 2; ++sub) {
                pg8::Gemm g; pg8::StaticOrder S; pg8::EpiBf16<0> E;
                if (sub == 0) { g = pg8::Gemm{(const pg8::bf16_t*)(ws + WS_XB), (const pg8::bf16_t*)(ws + WS_WIN), TOK, NPROJ, DM}; S.init(TOK, NPROJ, C.G, (int)blockIdx.x); E = pg8::EpiBf16<0>{(pg8::bf16_t*)(ws + WS_A), NPROJ, nullptr, 0, 0, 1.f}; }
                else { g = pg8::Gemm{(const pg8::bf16_t*)(ws + WS_PB), (const pg8::bf16_t*)(ws + WS_WU), TOK, DM, PLED}; S.init(TOK, DM, C.G, (int)blockIdx.x); E = pg8::EpiBf16<0>{(pg8::bf16_t*)(ws + WS_U), DM, nullptr, 0, 0, 1.f}; }
                pg8::gemm_phase<pg8::EpiBf16<0>, pg8::StaticOrder, true, true>(C.lds + RING_OFF, g, S, E);
            }
        }
        else if (k == 1) { ph_mixer(C, args, l, (char*)lds_raw); }
        else if (k == 2) { ph_combine(C, args, l); }
        else if (k == 3) {
            pg8::Gemm g{(const pg8::bf16_t*)(ws + WS_C), (const pg8::bf16_t*)(ws + WS_WO), TOK, DM, DM}; pg8::StaticOrder S; S.init(TOK, DM, C.G, (int)blockIdx.x);
            pg8::EpiResF32 E{l == 0 ? args.in[I_X] : (const float*)args.out, (float*)(ws + WS_A), DM, ALPHA};
            pg8::gemm_phase<pg8::EpiResF32, pg8::StaticOrder, true, true>(C.lds + RING_OFF, g, S, E);
        }
        else if (k == 4) { ph_ln1_router(C, args, l); }
        else if (k == 5) { ph_gather(C, args, l); }
        else if (k == 6) {
            build_ts(C, l);
            pg8::Gemm g{(const pg8::bf16_t*)(ws + WS_A), (const pg8::bf16_t*)(ws + WS_W1), SLOTS, NEXP * 1024, DM};
            pg8::MoeOrder S{(const LAS int*)(C.lds + TAB_OFF), 4, C.G, (int)blockIdx.x};
            pg8::EpiSwiglu E{(pg8::bf16_t*)(ws + WS_C), (const float*)(ws + WS_LW), (const int*)((const unsigned*)(ws + WS_CTL) + CW_CNT + 64 * l), (const LAS int*)(C.lds + TAB_OFF)};
            pg8::gemm_phase<pg8::EpiSwiglu, pg8::MoeOrder, true, true>(C.lds + RING_OFF, g, S, E);
        }
        else if (k == 7) {
            build_ts(C, l);
            { pg8::Gemm g{(const pg8::bf16_t*)(ws + WS_C), (const pg8::bf16_t*)(ws + WS_WD), SLOTS, NEXP * DM, DEXP};
              pg8::MoeOrder S{(const LAS int*)(C.lds + TAB_OFF), 8, C.G, (int)blockIdx.x};
              pg8::EpiStore E{(pg8::bf16_t*)(ws + WS_A), DM, 7};
              pg8::gemm_phase<pg8::EpiStore, pg8::MoeOrder, true, true>(C.lds + RING_OFF, g, S, E); }
            { pg8::Gemm g{(const pg8::bf16_t*)(ws + WS_HB), (const pg8::bf16_t*)(ws + WS_WG), TOK, DM, DM}; pg8::StaticOrder S; S.init(TOK, DM, C.G, (int)blockIdx.x);
              pg8::EpiPle E{(const pg8::bf16_t*)(ws + WS_U), (pg8::bf16_t*)(ws + WS_PLE), DM};
              pg8::gemm_phase<pg8::EpiPle, pg8::StaticOrder, true, true>(C.lds + RING_OFF, g, S, E); }
        }
        else { ph_ln2(C, args, l); }
        if (ph + 1 < args.ph_hi) xcd_barrier(bar);
    }
}

extern "C" void kernel_launch(void* const* d_in, const int* in_sizes, int n_in, void* d_out, int out_size, void* d_ws, size_t ws_size, hipStream_t stream) {
    static int grid = 0;
    if (grid == 0) {
        if (n_in != N_IN || out_size != TOK * DM || ws_size < WS_END) { fprintf(stderr, "kernel_launch: unexpected shapes n_in %d out %d ws %zu (need %zu)\n", n_in, out_size, ws_size, (size_t)WS_END); grid = -1; return; }
        int dev = 0, cus = 0;
        if (hipGetDevice(&dev) != hipSuccess || hipDeviceGetAttribute(&cus, hipDeviceAttributeMultiprocessorCount, dev) != hipSuccess) { grid = -1; return; }
        if (hipFuncSetAttribute((const void*)mk_fwd, hipFuncAttributeMaxDynamicSharedMemorySize, LDS_BYTES) != hipSuccess) { fprintf(stderr, "kernel_launch: hipFuncSetAttribute failed\n"); grid = -1; return; }
        (void)hipGetLastError();
        grid = cus;
    }
    if (grid < 0) return;
    if (hipMemsetAsync((char*)d_ws + WS_CTL, 0, CTL_ZERO_BYTES, stream) != hipSuccess) return;
    Args a{};
    for (int i = 0; i < N_IN; ++i) a.in[i] = (const float*)d_in[i];
    a.out = (float*)d_out; a.ws = (unsigned char*)d_ws;
#if MK_PER_PHASE
    for (int ph = 0; ph < NPHASE; ++ph) { a.ph_lo = ph; a.ph_hi = ph + 1; hipLaunchKernelGGL(mk_fwd, dim3(grid), dim3(NWAVES * 64), LDS_BYTES, stream, a); }
#else
    a.ph_lo = 0; a.ph_hi = NPHASE;
    hipLaunchKernelGGL(mk_fwd, dim3(grid), dim3(NWAVES * 64), LDS_BYTES, stream, a);
#endif
}
```

```cpp
#include <hip/hip_runtime.h>
#include <cstdio>
#include <cstdint>
#include <cmath>
namespace pg8 {
#define PG8_LAS __attribute__((address_space(3)))
typedef unsigned short bf16_t;
typedef short bf16x8 __attribute__((ext_vector_type(8)));
typedef float f32x4 __attribute__((ext_vector_type(4)));
typedef unsigned u32x4 __attribute__((ext_vector_type(4)));
constexpr int BM = 256, BK = 64, HALF = 128, HTB = HALF * BK * 2  , STAGE_BYTES = 8 * HTB, NXCD = 8, WGM = 8;

__host__ __device__ __forceinline__ int lds_byte(int r, int c) { const int st = (r >> 4) * 2 + (c >> 5), rr = r & 15, cc = c & 31, ob = rr * 64 + cc * 2; return st * 1024 + (ob ^ (((ob >> 9) & 1) << 5)); }
__host__ __device__ __forceinline__ void stage_rc(int b, int& R, int& C) { const int st = b / 1024, sb = b % 1024, swz = sb ^ (((sb >> 9) & 1) << 5); R = (st >> 1) * 16 + swz / 64; C = (st & 1) * 32 + (swz % 64) / 2; }
__host__ __device__ __forceinline__ int perm32(int rho) { const int n = rho >> 4, i = rho & 15; return 8 * (i >> 2) + 4 * n + (i & 3); }

struct Unit { int pm, pn; };
struct Gemm { const bf16_t* A; const bf16_t* Bt; int M, N, K; };

struct StaticOrder {
    int nM, nN, nwg, G, c;
    __host__ __device__ void init(int M, int N, int G_, int c_) { nM = M / BM; nN = N / BM; nwg = nM * nN; G = G_; c = c_; }
    __host__ __device__ bool next(int i, Unit& u) const {
        const long L = (long)i * G + c; if (L >= nwg) return false;
        int wgid = (int)L; { const int q = nwg / NXCD, r = nwg % NXCD, xcd = wgid % NXCD, off = wgid / NXCD; wgid = (xcd < r ? xcd * (q + 1) : r * (q + 1) + (xcd - r) * q) + off; }
        const int nig = WGM * nN, gid = wgid / nig, fm = gid * WGM, gsz = (nM - fm) < WGM ? (nM - fm) : WGM;
        u.pm = fm + ((wgid % nig) % gsz); u.pn = (wgid % nig) / gsz; return true;
    }
    __device__ __forceinline__ void a_ready(const Unit&) const {}
    __device__ __forceinline__ void done(const Unit&) const {}
};

__device__ __forceinline__ unsigned cvt_pk_bf16(float lo, float hi) { unsigned r; asm volatile("v_cvt_pk_bf16_f32 %0, %1, %2" : "=v"(r) : "v"(lo), "v"(hi)); return r; }
typedef float f32x2 __attribute__((ext_vector_type(2)));
__device__ __forceinline__ f32x2 gelu_pk(f32x2 v) {
    const f32x2 av = __builtin_elementwise_abs(v), d = av * 0.2316418882f + 1.0f;
    f32x2 t; t.x = __builtin_amdgcn_rcpf(d.x); t.y = __builtin_amdgcn_rcpf(d.y);
    f32x2 q = t * 0.5307027145f + (-0.7265760135f); q = q * t + 0.7107068705f; q = q * t + (-0.142248368f); q = q * t + 0.127414796f; q = q * t;
    const f32x2 s = (v * v) * (-0.72134752044f);
    f32x2 e; e.x = __builtin_amdgcn_exp2f(s.x); e.y = __builtin_amdgcn_exp2f(s.y);
    const f32x2 m = v * (q * e), r = v - m;
    f32x2 o; o.x = v.x < 0.f ? m.x : r.x; o.y = v.y < 0.f ? m.y : r.y; return o;
}

template <int ACT  > struct EpiBf16 {
    static constexpr bool PERM = true, AFTER_DRAIN = false; static_assert(ACT == 0 || ACT == 1, "EpiBf16: ACT is 0 (none) or 1 (gelu_pk)");
    bf16_t* O; int ldc; const float* bias; int split_cols; size_t split_stride; float scale0;
    __device__ __forceinline__ void operator()(const f32x4 (&acc)[2][2][4][2], const Unit& u, int wr, int wc, int fr, int fq) const {
        const int row0 = u.pm * BM + wr * 64 + fr; int colt = u.pn * BM; bf16_t* base = O;
        float sc = 1.f; if (split_cols) { const int t = colt / split_cols; base += (size_t)t * split_stride; colt -= t * split_cols; if (t == 0) sc = scale0; }
        const int col0 = colt + wc * 32 + 8 * fq, bcol0 = u.pn * BM + wc * 32 + 8 * fq;
        f32x4 bv[2][2];
#pragma unroll
        for (int bj = 0; bj < 2; ++bj)
#pragma unroll
            for (int n = 0; n < 2; ++n) bv[bj][n] = bias ? *(const f32x4*)(bias + bcol0 + bj * HALF + 4 * n) : (f32x4){0.f, 0.f, 0.f, 0.f};
#pragma unroll
        for (int ai = 0; ai < 2; ++ai)
#pragma unroll
            for (int m = 0; m < 4; ++m) { bf16_t* rowp = base + (size_t)(row0 + ai * HALF + m * 16) * ldc + col0;
#pragma unroll
                for (int bj = 0; bj < 2; ++bj) { f32x4 v0 = acc[ai][bj][m][0] + bv[bj][0], v1 = acc[ai][bj][m][1] + bv[bj][1];
                    if (ACT == 1) { f32x2 a = gelu_pk((f32x2){v0[0], v0[1]}), b = gelu_pk((f32x2){v0[2], v0[3]}), c = gelu_pk((f32x2){v1[0], v1[1]}), d = gelu_pk((f32x2){v1[2], v1[3]});
                        v0 = (f32x4){a.x, a.y, b.x, b.y}; v1 = (f32x4){c.x, c.y, d.x, d.y}; }
                    v0 = v0 * sc; v1 = v1 * sc; u32x4 w; w.x = cvt_pk_bf16(v0[0], v0[1]); w.y = cvt_pk_bf16(v0[2], v0[3]); w.z = cvt_pk_bf16(v1[0], v1[1]); w.w = cvt_pk_bf16(v1[2], v1[3]);
                    *(u32x4*)(rowp + bj * HALF) = w; } }
    }
};

struct PanelStats {
    unsigned* xbuf;
    unsigned* cnt;
    unsigned* tmo;
    int ntn; float eps;
    unsigned code;
    __device__ __forceinline__ bool run(const f32x4 (&v)[2][2][4][2], const Unit& u, int wr, int wc, int fr, int fq, PG8_LAS unsigned char* lds, int wid, int lane) const {
        typedef float f32x2v __attribute__((ext_vector_type(2)));
        PG8_LAS f32x2v* P = (PG8_LAS f32x2v*)lds;
        PG8_LAS f32x2v* S = (PG8_LAS f32x2v*)(lds + 8192);
        PG8_LAS unsigned* flag = (PG8_LAS unsigned*)(lds + 8192 + 2048);
#pragma unroll
        for (int ai = 0; ai < 2; ++ai)
#pragma unroll
            for (int m = 0; m < 4; ++m) {
                float s = 0.f;
#pragma unroll
                for (int bj = 0; bj < 2; ++bj)
#pragma unroll
                    for (int n = 0; n < 2; ++n) { const f32x4 x = v[ai][bj][m][n]; s += (x[0] + x[1]) + (x[2] + x[3]); }
                s += __shfl_xor(s, 16); s += __shfl_xor(s, 32);
                const float mw = s * (1.0f / 64.0f); float q = 0.f;
#pragma unroll
                for (int bj = 0; bj < 2; ++bj)
#pragma unroll
                    for (int n = 0; n < 2; ++n) { const f32x4 d = v[ai][bj][m][n] - mw; q += (d[0] * d[0] + d[1] * d[1]) + (d[2] * d[2] + d[3] * d[3]); }
                q += __shfl_xor(q, 16); q += __shfl_xor(q, 32);
                if (fq == 0) P[(ai * HALF + wr * 64 + m * 16 + fr) * 4 + wc] = (f32x2v){mw, q};
            }
        asm volatile("s_waitcnt lgkmcnt(0)" ::: "memory"); __builtin_amdgcn_s_barrier(); asm volatile("" ::: "memory");
#if defined(BROKEN_EXCHANGE_NO_WAIT)
#warning BROKEN CONTROL BUILD: the row-statistics exchange does not wait; results are wrong by design
        if (blockIdx.x >= 64) { const long long t0_ = clock64(); while (clock64() - t0_ < 60000) __builtin_amdgcn_s_sleep(8); }
#endif
        const int row = wid * 32 + (lane & 31);
        if (lane < 32) {
            const f32x2v a = P[row * 4 + 0], b = P[row * 4 + 1], c = P[row * 4 + 2], d = P[row * 4 + 3];
            const float mt = (a.x + b.x + c.x + d.x) * 0.25f;
            const float da = a.x - mt, db = b.x - mt, dc = c.x - mt, dd = d.x - mt;
            const float m2 = (a.y + b.y) + (c.y + d.y) + 64.0f * ((da * da + db * db) + (dc * dc + dd * dd));
            unsigned long long* slot = (unsigned long long*)xbuf + ((size_t)(u.pm * BM + row) * 4 + u.pn);
            __hip_atomic_store(slot, ((unsigned long long)__float_as_uint(m2) << 32) | __float_as_uint(mt), __ATOMIC_RELAXED, __HIP_MEMORY_SCOPE_AGENT);
        }
        asm volatile("s_waitcnt vmcnt(0)" ::: "memory");
        if (lane == 0) __hip_atomic_fetch_add(cnt + 64 * u.pm, 1u, __ATOMIC_RELAXED, __HIP_MEMORY_SCOPE_AGENT);
        if (wid == 0) {
            bool dead = false; const unsigned long long t0 = __builtin_amdgcn_s_memrealtime(); const unsigned want = 8u * (unsigned)ntn;
            for (;;) {
#if defined(BROKEN_EXCHANGE_NO_WAIT)
                break;
#endif
                if ((unsigned)__builtin_amdgcn_readfirstlane(__hip_atomic_load(cnt + 64 * u.pm, __ATOMIC_RELAXED, __HIP_MEMORY_SCOPE_AGENT)) >= want) break;
                if (__builtin_amdgcn_s_memrealtime() - t0 > 2000000ull) {
                    if (lane == 0) { unsigned expect = 0u; __hip_atomic_compare_exchange_strong(tmo + 1, &expect, code | (unsigned)(u.pm & 0xff), __ATOMIC_RELAXED, __ATOMIC_RELAXED, __HIP_MEMORY_SCOPE_AGENT);
                                     __hip_atomic_store(tmo, 1u, __ATOMIC_RELAXED, __HIP_MEMORY_SCOPE_AGENT); }
                    dead = true; break; }
                __builtin_amdgcn_s_sleep(2);
            }
            __builtin_amdgcn_fence(__ATOMIC_ACQUIRE, "agent");
            if (lane == 0) flag[0] = dead ? 1u : 0u;
        }
        asm volatile("s_waitcnt vmcnt(0) lgkmcnt(0)" ::: "memory"); __builtin_amdgcn_s_barrier(); asm volatile("" ::: "memory");
        const bool bad = flag[0] != 0u;
        if (lane < 32) {
            const unsigned long long* slot = (const unsigned long long*)xbuf + (size_t)(u.pm * BM + row) * 4; float mt[4], m2[4]; float ms = 0.f;
#pragma unroll
            for (int t = 0; t < 4; ++t) { if (t < ntn) { const unsigned long long w = __hip_atomic_load(slot + t, __ATOMIC_RELAXED, __HIP_MEMORY_SCOPE_AGENT); mt[t] = __uint_as_float((unsigned)w); m2[t] = __uint_as_float((unsigned)(w >> 32)); } else { mt[t] = 0.f; m2[t] = 0.f; } ms += mt[t]; }
            const float mean = ms / (float)ntn; float q = 0.f;
#pragma unroll
            for (int t = 0; t < 4; ++t) if (t < ntn) { const float dm = mt[t] - mean; q += m2[t] + 256.0f * dm * dm; }
            S[row] = (f32x2v){mean, 1.0f / sqrtf(q / (256.0f * (float)ntn) + eps)};
        }
        asm volatile("s_waitcnt lgkmcnt(0)" ::: "memory"); __builtin_amdgcn_s_barrier(); asm volatile("" ::: "memory");
        return bad;
    }
};
struct EpiLnRes {
    static constexpr bool PERM = false, AFTER_DRAIN = true;
    const float* base; float* out; int ldc; const float* bias; PanelStats st; unsigned poison;
    __device__ __forceinline__ void fused(f32x4 (&acc)[2][2][4][2], const Unit& u, int wr, int wc, int fr, int fq, PG8_LAS unsigned char* lds, int wid, int lane) const {
        typedef float f32x2v __attribute__((ext_vector_type(2)));
        const PG8_LAS f32x2v* S = (const PG8_LAS f32x2v*)(lds + 8192);
        const int col0 = u.pn * BM + wc * 32 + 4 * fq;
#pragma unroll
        for (int bj = 0; bj < 2; ++bj)
#pragma unroll
            for (int n = 0; n < 2; ++n) { const f32x4 bv = bias ? *(const f32x4*)(bias + col0 + bj * HALF + n * 16) : (f32x4){0.f, 0.f, 0.f, 0.f};
#pragma unroll
                for (int ai = 0; ai < 2; ++ai)
#pragma unroll
                    for (int m = 0; m < 4; ++m) acc[ai][bj][m][n] += bv; }
        f32x4 pre[4][2][2];
#pragma unroll
        for (int m = 0; m < 4; ++m) { const size_t off = (size_t)(u.pm * BM + wr * 64 + m * 16 + fr) * ldc + col0;
#pragma unroll
            for (int bj = 0; bj < 2; ++bj)
#pragma unroll
                for (int n = 0; n < 2; ++n) pre[m][bj][n] = *(const f32x4*)(base + off + bj * HALF + n * 16); }
        const bool bad = st.run(acc, u, wr, wc, fr, fq, lds, wid, lane) || poison != 0u;
        const float qnan = __builtin_nanf("");
#pragma unroll
        for (int ai = 0; ai < 2; ++ai)
#pragma unroll
            for (int m = 0; m < 4; ++m) { const int r = ai * HALF + wr * 64 + m * 16 + fr; const f32x2v sr = S[r]; const size_t off = (size_t)(u.pm * BM + r) * ldc + col0;
#pragma unroll
                for (int bj = 0; bj < 2; ++bj)
#pragma unroll
                    for (int n = 0; n < 2; ++n) { const f32x4 bs = ai == 0 ? pre[m][bj][n] : *(const f32x4*)(base + off + bj * HALF + n * 16); f32x4 o = bs + (acc[ai][bj][m][n] - sr.x) * sr.y;
                        if (bad) o = (f32x4){qnan, qnan, qnan, qnan}; *(f32x4*)(out + off + bj * HALF + n * 16) = o; }
                if (m & 1) asm volatile("" ::: "memory"); }
    }
};
struct EpiLnResLn {
    static constexpr bool PERM = false, AFTER_DRAIN = true;
    const float* base; float* out; bf16_t* xn; int ldc; const float* bias; PanelStats st1, st2; unsigned poison;
    __device__ __forceinline__ void fused(f32x4 (&acc)[2][2][4][2], const Unit& u, int wr, int wc, int fr, int fq, PG8_LAS unsigned char* lds, int wid, int lane) const {
        typedef float f32x2v __attribute__((ext_vector_type(2))); typedef unsigned u32x2v __attribute__((ext_vector_type(2)));
        const PG8_LAS f32x2v* S = (const PG8_LAS f32x2v*)(lds + 8192);
        const int col0 = u.pn * BM + wc * 32 + 4 * fq;
#pragma unroll
        for (int bj = 0; bj < 2; ++bj)
#pragma unroll
            for (int n = 0; n < 2; ++n) { const f32x4 bv = bias ? *(const f32x4*)(bias + col0 + bj * HALF + n * 16) : (f32x4){0.f, 0.f, 0.f, 0.f};
#pragma unroll
                for (int ai = 0; ai < 2; ++ai)
#pragma unroll
                    for (int m = 0; m < 4; ++m) acc[ai][bj][m][n] += bv; }
        bool bad = st1.run(acc, u, wr, wc, fr, fq, lds, wid, lane) || poison != 0u;
        const float qnan = __builtin_nanf("");
#pragma unroll
        for (int ai = 0; ai < 2; ++ai)
#pragma unroll
            for (int m = 0; m < 4; ++m) { const int r = ai * HALF + wr * 64 + m * 16 + fr; const f32x2v sr = S[r]; const size_t off = (size_t)(u.pm * BM + r) * ldc + col0;
#pragma unroll
                for (int bj = 0; bj < 2; ++bj)
#pragma unroll
                    for (int n = 0; n < 2; ++n) { const f32x4 bs = *(const f32x4*)(base + off + bj * HALF + n * 16); acc[ai][bj][m][n] = bs + (acc[ai][bj][m][n] - sr.x) * sr.y; }
                asm volatile("" : "+v"(acc[ai][0][m][0]), "+v"(acc[ai][0][m][1]), "+v"(acc[ai][1][m][0]), "+v"(acc[ai][1][m][1]));
                if (m & 1) asm volatile("" ::: "memory"); }
        const bool bad1 = bad;
        bad = st2.run(acc, u, wr, wc, fr, fq, lds, wid, lane) || bad;
#pragma unroll
        for (int ai = 0; ai < 2; ++ai)
#pragma unroll
            for (int m = 0; m < 4; ++m) { const int r = ai * HALF + wr * 64 + m * 16 + fr; const f32x2v sr = S[r]; const size_t off = (size_t)(u.pm * BM + r) * ldc + col0;
#pragma unroll
                for (int bj = 0; bj < 2; ++bj)
#pragma unroll
                    for (int n = 0; n < 2; ++n) { const f32x4 x1 = acc[ai][bj][m][n]; *(f32x4*)(out + off + bj * HALF + n * 16) = bad1 ? (f32x4){qnan, qnan, qnan, qnan} : x1;
                        const f32x4 o = (x1 - sr.x) * sr.y; u32x2v w; w.x = cvt_pk_bf16(o[0], o[1]); w.y = cvt_pk_bf16(o[2], o[3]);
                        if (bad) { w.x = 0x7fc07fc0u; w.y = 0x7fc07fc0u; } *(u32x2v*)(xn + off + bj * HALF + n * 16) = w; }
                asm volatile("" ::: "memory"); }
    }
};

template <class Epi, class Sched, bool ALIGN_EPI = false, bool SP2 = false>
__device__ __forceinline__ void gemm_phase(PG8_LAS unsigned char* lds, const Gemm g, const Sched& S, const Epi& E, const int wave0) {
    int lane_; asm volatile("v_mbcnt_lo_u32_b32 %0, -1, 0\n\tv_mbcnt_hi_u32_b32 %0, -1, %0" : "=v"(lane_));
    const int wid = wave0, lane = lane_, tid = wid * 64 + lane, wr = wid >> 2, wc = wid & 3, fr = lane & 15, fq = lane >> 4;
    const int K = g.K, nt = K / BK;
    unsigned voffA[2], voffB[2];
#pragma unroll
    for (int i = 0; i < 2; ++i) { int R, C; stage_rc(tid * 16 + i * 8192, R, C); const int Rb = Epi::PERM ? ((R & ~31) + perm32(R & 31)) : R;
        voffA[i] = (unsigned)(R * K + C) * 2u; voffB[i] = (unsigned)(Rb * K + C) * 2u; }
    const size_t kstep = (size_t)(BK * 2);
    const size_t hstep = (size_t)HALF * K * 2;
    const size_t tstep = 2 * hstep;
    const unsigned ldsw = (unsigned)wid * 1024u;
    const int aoff = lds_byte(wr * 64 + fr, fq * 8), boff = lds_byte(wc * 32 + fr, fq * 8);
#define PG8_SA(b, h) (((b) * 2 + (h)) * HTB)
#define PG8_SB(b, h) ((4 + (b) * 2 + (h)) * HTB)
#define PG8_STAGE(bufoff, gbase, voff) do { _Pragma("unroll") for (int _i = 0; _i < 2; ++_i) \
        __builtin_amdgcn_global_load_lds((const unsigned*)((const char*)(gbase) + (voff)[_i]), (PG8_LAS unsigned*)(lds + (bufoff) + ldsw + _i * 8192), 16, 0, 0); } while (0)
#define PG8_LDA(dst, b, h) do { _Pragma("unroll") for (int m = 0; m < 4; ++m) _Pragma("unroll") for (int k = 0; k < 2; ++k) dst[m][k] = *(const PG8_LAS bf16x8*)(lds + PG8_SA(b, h) + aoff + m * 2048 + k * 1024); } while (0)
#define PG8_LDB(dst, b, h) do { _Pragma("unroll") for (int n = 0; n < 2; ++n) _Pragma("unroll") for (int k = 0; k < 2; ++k) dst[n][k] = *(const PG8_LAS bf16x8*)(lds + PG8_SB(b, h) + boff + n * 2048 + k * 1024); } while (0)
#define PG8_MMA(ai, bj, At, Bt) do { __builtin_amdgcn_s_setprio(1); _Pragma("unroll") for (int m = 0; m < 4; ++m) _Pragma("unroll") for (int n = 0; n < 2; ++n) _Pragma("unroll") for (int k = 0; k < 2; ++k) \
        acc[ai][bj][m][n] = __builtin_amdgcn_mfma_f32_16x16x32_bf16(Bt[n][k], At[m][k], acc[ai][bj][m][n], 0, 0, 0); __builtin_amdgcn_s_setprio(0); } while (0)
#define PG8_WAIT_V(n) asm volatile("s_waitcnt vmcnt(" #n ")" ::: "memory")
#define PG8_WAIT_L(n) asm volatile("s_waitcnt lgkmcnt(" #n ")" ::: "memory")
#define PG8_BAR __builtin_amdgcn_s_barrier()
#define PG8_SCHED __builtin_amdgcn_sched_barrier(0)
    Unit cur, nxt; int ui = 0;
    if (!S.next(0, cur)) return;
    f32x4 acc[2][2][4][2];
#pragma unroll
    for (int a = 0; a < 2; ++a)
#pragma unroll
        for (int b = 0; b < 2; ++b)
#pragma unroll
            for (int m = 0; m < 4; ++m)
#pragma unroll
                for (int n = 0; n < 2; ++n) acc[a][b][m][n] = (f32x4){0.f, 0.f, 0.f, 0.f};
    bf16x8 At[4][2], B0[2][2], B1[2][2];
    const char* cA = (const char*)g.A + (size_t)cur.pm * tstep; const char* cB = (const char*)g.Bt + (size_t)cur.pn * tstep;
    S.a_ready(cur);
    if constexpr (SP2) {
        PG8_STAGE(PG8_SB(0, 0), cB, voffB); PG8_STAGE(PG8_SB(0, 1), cB + hstep, voffB); PG8_STAGE(PG8_SA(0, 0), cA, voffA); PG8_STAGE(PG8_SA(0, 1), cA + hstep, voffA);
        if (wr == 1) PG8_BAR;
        PG8_WAIT_V(2); PG8_BAR;
        PG8_STAGE(PG8_SB(1, 0), cB + kstep, voffB); PG8_STAGE(PG8_SA(1, 0), cA + kstep, voffA); PG8_STAGE(PG8_SB(1, 1), cB + hstep + kstep, voffB);
        PG8_WAIT_V(6); PG8_BAR;
    } else {
        PG8_STAGE(PG8_SB(0, 0), cB, voffB); PG8_STAGE(PG8_SA(0, 0), cA, voffA); PG8_STAGE(PG8_SB(0, 1), cB + hstep, voffB); PG8_STAGE(PG8_SA(0, 1), cA + hstep, voffA);
        if (wr == 1) PG8_BAR;
        PG8_WAIT_V(4); PG8_BAR;
        PG8_STAGE(PG8_SB(1, 0), cB + kstep, voffB); PG8_STAGE(PG8_SA(1, 0), cA + kstep, voffA); PG8_STAGE(PG8_SB(1, 1), cB + hstep + kstep, voffB);
        PG8_WAIT_V(6); PG8_BAR;
    }
    for (;;) {
        const bool has_next = S.next(ui + 1, nxt);
        const char* nA = has_next ? (const char*)g.A + (size_t)nxt.pm * tstep : cA; const char* nB = has_next ? (const char*)g.Bt + (size_t)nxt.pn * tstep : cB;
        for (int t = 0; t < nt; t += 2) {
            const bool last = (t == nt - 2);
            const char* a1 = cA + (size_t)(t + 1) * kstep;
            const char* a2 = last ? nA : cA + (size_t)(t + 2) * kstep; const char* b2 = last ? nB : cB + (size_t)(t + 2) * kstep;
            const char* a3 = a2 + kstep; const char* b3 = b2 + kstep;
            if (last && has_next) S.a_ready(nxt);
            if constexpr (SP2) {
            PG8_LDB(B0, 0, 0); PG8_LDB(B1, 0, 1); PG8_SCHED; PG8_LDA(At, 0, 0); PG8_STAGE(PG8_SA(1, 1), a1 + hstep, voffA);
            PG8_WAIT_V(8); PG8_WAIT_L(0); PG8_BAR; PG8_MMA(0, 0, At, B0); PG8_MMA(0, 1, At, B1); PG8_BAR; PG8_SCHED;
            PG8_LDA(At, 0, 1); PG8_STAGE(PG8_SB(0, 0), b2, voffB); PG8_STAGE(PG8_SB(0, 1), b2 + hstep, voffB); PG8_STAGE(PG8_SA(0, 0), a2, voffA);
            PG8_WAIT_V(8); PG8_WAIT_L(0); PG8_BAR; PG8_MMA(1, 0, At, B0); PG8_MMA(1, 1, At, B1); PG8_BAR; PG8_SCHED;
            PG8_LDB(B0, 1, 0); PG8_LDB(B1, 1, 1); PG8_SCHED; PG8_LDA(At, 1, 0); PG8_STAGE(PG8_SA(0, 1), a2 + hstep, voffA);
            PG8_WAIT_V(8); PG8_WAIT_L(0); PG8_BAR; PG8_MMA(0, 0, At, B0); PG8_MMA(0, 1, At, B1); PG8_BAR; PG8_SCHED;
            PG8_LDA(At, 1, 1); PG8_STAGE(PG8_SB(1, 0), b3, voffB); PG8_STAGE(PG8_SB(1, 1), b3 + hstep, voffB); PG8_STAGE(PG8_SA(1, 0), a3, voffA);
            PG8_WAIT_V(8); PG8_WAIT_L(0); PG8_BAR; PG8_MMA(1, 0, At, B0); PG8_MMA(1, 1, At, B1); PG8_BAR; PG8_SCHED;
            } else {
            PG8_LDB(B0, 0, 0); PG8_SCHED; PG8_LDA(At, 0, 0); PG8_STAGE(PG8_SA(1, 1), a1 + hstep, voffA);
            PG8_WAIT_L(8); PG8_BAR; PG8_WAIT_L(0); PG8_MMA(0, 0, At, B0); PG8_BAR; PG8_SCHED;
            PG8_LDB(B1, 0, 1); PG8_STAGE(PG8_SB(0, 0), b2, voffB);
            PG8_BAR; PG8_WAIT_L(0); PG8_MMA(0, 1, At, B1); PG8_BAR;
            PG8_LDA(At, 0, 1); PG8_STAGE(PG8_SA(0, 0), a2, voffA);
            PG8_BAR; PG8_WAIT_L(0); PG8_MMA(1, 0, At, B0); PG8_BAR; PG8_SCHED;
            PG8_STAGE(PG8_SB(0, 1), b2 + hstep, voffB);
            PG8_WAIT_V(6); PG8_BAR; PG8_MMA(1, 1, At, B1); PG8_BAR;
            PG8_LDB(B0, 1, 0); PG8_SCHED; PG8_LDA(At, 1, 0); PG8_STAGE(PG8_SA(0, 1), a2 + hstep, voffA);
            PG8_WAIT_L(8); PG8_BAR; PG8_WAIT_L(0); PG8_MMA(0, 0, At, B0); PG8_BAR; PG8_SCHED;
            PG8_LDB(B1, 1, 1); PG8_STAGE(PG8_SB(1, 0), b3, voffB);
            PG8_BAR; PG8_WAIT_L(0); PG8_MMA(0, 1, At, B1); PG8_BAR;
            PG8_LDA(At, 1, 1); PG8_STAGE(PG8_SA(1, 0), a3, voffA);
            PG8_BAR; PG8_WAIT_L(0); PG8_MMA(1, 0, At, B0); PG8_BAR; PG8_SCHED;
            PG8_STAGE(PG8_SB(1, 1), b3 + hstep, voffB);
            PG8_WAIT_V(6); PG8_BAR; PG8_MMA(1, 1, At, B1); PG8_BAR;
            }
        }
        if constexpr (ALIGN_EPI) { if (wr == 0) PG8_BAR; }
        if constexpr (!Epi::AFTER_DRAIN) { E(acc, cur, wr, wc, fr, fq); S.done(cur); }
        if (!has_next) break;
#pragma unroll
        for (int a = 0; a < 2; ++a)
#pragma unroll
            for (int b = 0; b < 2; ++b)
#pragma unroll
                for (int m = 0; m < 4; ++m)
#pragma unroll
                    for (int n = 0; n < 2; ++n) acc[a][b][m][n] = (f32x4){0.f, 0.f, 0.f, 0.f};
        cur = nxt; cA = nA; cB = nB; ++ui;
        if constexpr (ALIGN_EPI) { if (wr == 1) PG8_BAR; }
    }
    PG8_WAIT_V(0);
    if constexpr (!ALIGN_EPI) { if (wr == 0) PG8_BAR; }
    PG8_BAR;
    if constexpr (Epi::AFTER_DRAIN) { E.fused(acc, cur, wr, wc, fr, fq, lds, wid, lane); S.done(cur); }
#undef PG8_SA
#undef PG8_SB
#undef PG8_STAGE
#undef PG8_LDA
#undef PG8_LDB
#undef PG8_MMA
#undef PG8_WAIT_V
#undef PG8_WAIT_L
#undef PG8_BAR
#undef PG8_SCHED
}
}
#include <hip/hip_bf16.h>
#include <cmath>
namespace attn_body {
using bf16=__hip_bfloat16;
using bf16x8=__attribute__((ext_vector_type(8)))short;
using s16x4=__attribute__((ext_vector_type(4)))short;
using f32x16=__attribute__((ext_vector_type(16)))float;
using u32x4=__attribute__((ext_vector_type(4)))unsigned;
constexpr int D=64,DM=4608;
constexpr int NW=8,QBLK=32,QB=QBLK*NW,KVBLK=64;
constexpr int M_KB=1,M_DIST=2,M_WIN=4;
constexpr int ATTN_PITCH=DM, ATTN_UNIT_ROWS=QB;
__device__ __forceinline__ int crow(int r,int hi){return (r&3)+8*(r>>2)+4*hi;}
#define SBAR() __builtin_amdgcn_sched_barrier(0)
__device__ __forceinline__ void cmask(f32x16&p0,f32x16&p1,int jb,int qrel,int hi){
  const float NEG=-INFINITY; int kb=64*jb+4*hi;
  #pragma unroll
  for(int r=0;r<16;++r){int kv=kb+(r&3)+8*(r>>2); if(kv>qrel)p0[r]=NEG; if(kv+32>qrel)p1[r]=NEG;}
}

typedef __attribute__((address_space(3))) const float* lds_fptr;
typedef float f32x4_t __attribute__((ext_vector_type(4)));
template<int MODE> __device__ __forceinline__ void fix_tile(f32x16&p0,f32x16&p1,int kvoff,int qrel,int hi,lds_fptr dtl){
  const float NEG=-INFINITY;
  int db=qrel-kvoff-4*hi; asm volatile("":"+v"(db));
  if constexpr((MODE&M_DIST)!=0){ if(kvoff>-192){
    #pragma unroll
    for(int r=0;r<16;++r){int d0=db-((r&3)+8*(r>>2)); int d1=d0-32; d0=d0<0?0:(d0>128?128:d0); d1=d1<0?0:(d1>128?128:d1); p0[r]+=dtl[d0]; p1[r]+=dtl[d1]; if((r&3)==3)__builtin_amdgcn_sched_barrier(0);} } }
  if(kvoff>=0){
    #pragma unroll
    for(int r=0;r<16;++r){const int d0=db-((r&3)+8*(r>>2)); if(d0<0)p0[r]=NEG; if(d0<32)p1[r]=NEG;} }
  if constexpr((MODE&M_WIN)!=0){ {
    #pragma unroll
    for(int r=0;r<16;++r){const int d0=db-((r&3)+8*(r>>2)); if(d0>=128)p0[r]=NEG; if(d0-32>=128)p1[r]=NEG;} } }
}
__device__ __forceinline__ void kbias(f32x16&p0,f32x16&p1,lds_fptr kp,int hi){
  #pragma unroll
  for(int g=0;g<4;++g){ const f32x4_t a=*(const __attribute__((address_space(3))) f32x4_t*)(kp+4*hi+8*g), b=*(const __attribute__((address_space(3))) f32x4_t*)(kp+32+4*hi+8*g);
    #pragma unroll
    for(int i=0;i<4;++i){p0[4*g+i]+=a[i];p1[4*g+i]+=b[i];} __builtin_amdgcn_sched_barrier(0); }
}

constexpr int NSLOT=3, SLOTB=8192;
constexpr int LDS_K=0, LDS_V=NSLOT*SLOTB, LDS_WS=2*NSLOT*SLOTB, LDS_OST=LDS_WS+NW*64*4, LDS_BYTES=LDS_OST+NW*4096;
constexpr float C2=0.125f*1.4426950408889634f;
__device__ __forceinline__ void glds16(const void*gsrc,unsigned lds_dst){unsigned keep;
  asm volatile("s_mov_b32 %0, m0\n\ts_mov_b32 m0, %2\n\ts_nop 0\n\tglobal_load_lds_dwordx4 %1, off\n\ts_mov_b32 m0, %0":"=&s"(keep):"v"(gsrc),"s"(lds_dst):"memory");}
__device__ __forceinline__ float max3f(float a,float b,float c){float r;asm("v_max3_f32 %0, %1, %2, %3":"=v"(r):"v"(a),"v"(b),"v"(c));return r;}
__device__ __forceinline__ float max2f(float a,float b){float r;asm("v_max_f32_e32 %0, %1, %2":"=v"(r):"v"(a),"v"(b));return r;}
__device__ __forceinline__ float fadd_s(float a,float b){float r;asm("v_add_f32_e32 %0, %1, %2":"=v"(r):"v"(a),"v"(b));return r;}
__device__ __forceinline__ float fsub_s(float a,float b){float r;asm("v_sub_f32_e32 %0, %1, %2":"=v"(r):"v"(a),"v"(b));return r;}
typedef float f32x2_t __attribute__((ext_vector_type(2))); typedef __bf16 bf16x2_t __attribute__((ext_vector_type(2)));
__device__ __forceinline__ unsigned cvtpk_s(float lo,float hi){f32x2_t v={lo,hi};bf16x2_t b=__builtin_convertvector(v,bf16x2_t);return __builtin_bit_cast(unsigned,b);}
#define WAIT_BAR(N) asm volatile("s_waitcnt vmcnt(" #N ") lgkmcnt(0)\n\ts_barrier":::"memory")

__device__ __forceinline__ void qkt(f32x16&p0,f32x16&p1,const char*Kslot,const bf16x8*qr,const f32x16&negm,int r32,int hi){
  const char*kb=Kslot+hi*1024+r32*16;
  #pragma unroll
  for(int d0=0;d0<4;++d0){
    const bf16x8 b0=*reinterpret_cast<const bf16x8*>(kb+d0*2048);
    const bf16x8 b1=*reinterpret_cast<const bf16x8*>(kb+d0*2048+512);
    if(d0==0){p0=__builtin_amdgcn_mfma_f32_32x32x16_bf16(b0,qr[0],negm,0,0,0);p1=__builtin_amdgcn_mfma_f32_32x32x16_bf16(b1,qr[0],negm,0,0,0);}
    else{p0=__builtin_amdgcn_mfma_f32_32x32x16_bf16(b0,qr[d0],p0,0,0,0);p1=__builtin_amdgcn_mfma_f32_32x32x16_bf16(b1,qr[d0],p1,0,0,0);}}
}
typedef __attribute__((address_space(3))) const char* lds_cptr;
typedef short v4i16_t __attribute__((ext_vector_type(4)));
__device__ __forceinline__ void kload8(bf16x8*kf,lds_cptr kp){
  kf[0]=*(const __attribute__((address_space(3))) bf16x8*)(kp);      kf[1]=*(const __attribute__((address_space(3))) bf16x8*)(kp+512);
  kf[2]=*(const __attribute__((address_space(3))) bf16x8*)(kp+2048); kf[3]=*(const __attribute__((address_space(3))) bf16x8*)(kp+2560);
  kf[4]=*(const __attribute__((address_space(3))) bf16x8*)(kp+4096); kf[5]=*(const __attribute__((address_space(3))) bf16x8*)(kp+4608);
  kf[6]=*(const __attribute__((address_space(3))) bf16x8*)(kp+6144); kf[7]=*(const __attribute__((address_space(3))) bf16x8*)(kp+6656);
}
__device__ __forceinline__ void kload2(bf16x8*kf,lds_cptr kp,int j){ kf[2*j]=*(const __attribute__((address_space(3))) bf16x8*)(kp+j*2048); kf[2*j+1]=*(const __attribute__((address_space(3))) bf16x8*)(kp+j*2048+512); }
__device__ __forceinline__ s16x4 vtr(lds_cptr p){ return __builtin_bit_cast(s16x4,__builtin_amdgcn_ds_read_tr16_b64_v4i16((__attribute__((address_space(3))) v4i16_t*)p)); }
__device__ __forceinline__ float rowmax(const f32x16&p0,const f32x16&p1){
  float a=max3f(p0[0],p0[1],p1[0]),b=max3f(p0[2],p0[3],p1[1]);a=max3f(a,p1[2],p1[3]);
  #pragma unroll
  for(int r=4;r<16;r+=4){a=max3f(a,p0[r],p0[r+1]);b=max3f(b,p0[r+2],p0[r+3]);a=max3f(a,p1[r],p1[r+1]);b=max3f(b,p1[r+2],p1[r+3]);}
  const float m=max2f(a,b);
  auto rr=__builtin_amdgcn_permlane32_swap(__float_as_uint(m),__float_as_uint(m),false,false);
  return max2f(__uint_as_float(rr[0]),__uint_as_float(rr[1]));
}
__device__ __forceinline__ void pv(f32x16*o,int vb,bf16x8 pa0,bf16x8 pa1,bf16x8 pa2,bf16x8 pa3){
  #pragma unroll
  for(int d0=0;d0<2;++d0){s16x4 lo[4],hi[4];
    #pragma unroll
    for(int ks=0;ks<4;++ks){
      asm volatile("ds_read_b64_tr_b16 %0,%1 offset:%c2":"=&v"(lo[ks]):"v"(vb),"i"(d0*4096+ks*1024):"memory");
      asm volatile("ds_read_b64_tr_b16 %0,%1 offset:%c2":"=&v"(hi[ks]):"v"(vb),"i"(d0*4096+ks*1024+512):"memory");}
    asm volatile("s_waitcnt lgkmcnt(0)":::"memory");SBAR();
    #define PK(k) (bf16x8){lo[k][0],lo[k][1],lo[k][2],lo[k][3],hi[k][0],hi[k][1],hi[k][2],hi[k][3]}
    o[d0]=__builtin_amdgcn_mfma_f32_32x32x16_bf16(pa0,PK(0),o[d0],0,0,0);
    o[d0]=__builtin_amdgcn_mfma_f32_32x32x16_bf16(pa1,PK(1),o[d0],0,0,0);
    o[d0]=__builtin_amdgcn_mfma_f32_32x32x16_bf16(pa2,PK(2),o[d0],0,0,0);
    o[d0]=__builtin_amdgcn_mfma_f32_32x32x16_bf16(pa3,PK(3),o[d0],0,0,0);
    #undef PK
  }
}

#ifndef ATTN_STORE16
#define ATTN_STORE16(p,v) (*(u32x4*)(p)=(v))
#endif
template<int MODE,int THRL> __device__ __forceinline__ void attn_unit(const bf16*Qg,const bf16*__restrict__ Kg,const bf16*__restrict__ Vg,bf16*Og,int opitch,int q0,int t_first,int NT,lds_fptr kbl,lds_fptr dtl,float sink2,char*shm,const int wave0){
  int lane_; asm volatile("v_mbcnt_lo_u32_b32 %0, -1, 0\n\tv_mbcnt_hi_u32_b32 %0, -1, %0":"=v"(lane_));
  const int wid=wave0,lane=lane_,tid=wid*64+lane,r32=lane&31,hi=lane>>5; (void)tid;
  const bf16*Qw=Qg+(long)(q0+wid*QBLK)*DM;
  const bf16*Kh=Kg+(long)t_first*KVBLK*DM,*Vh=Vg+(long)t_first*KVBLK*DM;
  const unsigned lds0=(unsigned)(uintptr_t)shm;
  float*wsf=(float*)(shm+LDS_WS)+wid*64;
  const bf16*ksrc=Kh+(long)lane*DM+wid*8;
  const bf16*vsrc=Vh+(long)(16*(wid&3)+(lane>>2))*DM+(wid>>2)*32+(lane&3)*8;
  const unsigned kdst=lds0+LDS_K+wid*1024, vdst=lds0+LDS_V+wid*1024;
  #define DMA_K(t,slot) glds16(ksrc+(long)(t)*KVBLK*DM,(unsigned)__builtin_amdgcn_readfirstlane(kdst+(slot)))
  #define DMA_V(t,slot) glds16(vsrc+(long)(t)*KVBLK*DM,(unsigned)__builtin_amdgcn_readfirstlane(vdst+(slot)))
  const int vb0=(int)(lds0+LDS_V)+((lane>>4)&1)*32+(lane&3)*8+(4*hi+((lane&15)>>2))*64;
  const char*Kbase=shm+LDS_K; bf16x8 kf[8];
  const lds_cptr shm3=(lds_cptr)shm; const lds_cptr kp0=shm3+LDS_K+hi*1024+r32*16; const lds_cptr vp0=shm3+LDS_V+((lane>>4)&1)*32+(lane&3)*8+(4*hi+((lane&15)>>2))*64;
  DMA_K(0,0);DMA_V(0,0);DMA_K(1,SLOTB);
  bf16x8 qr[4];
  #pragma unroll
  for(int d0=0;d0<4;++d0)qr[d0]=*reinterpret_cast<const bf16x8*>(&Qw[(long)r32*DM+d0*16+hi*8]);
  float mhat=0.f,l_reg=0.f;f32x16 o[2];o[0]=f32x16{};o[1]=f32x16{};f32x16 negm=f32x16{};asm volatile("":"+v"(negm));
  const int qrel=wid*QBLK+r32;
  #define CMASK(P0,P1,t) do{ if constexpr((MODE&M_KB)!=0) kbias(P0,P1,kbl+64*((t)+t_first),hi); fix_tile<MODE>(P0,P1,64*((t)+t_first)-q0,qrel,hi,dtl); }while(0)
  #define KBONLY(P0,P1,t) do{ if constexpr((MODE&M_KB)!=0) kbias(P0,P1,kbl+64*((t)+t_first),hi); }while(0)
  bool unset=false;
  bool resc=false;
  #define START(P0,P1) do{ const float rm=rowmax(P0,P1); resc=false; \
    { float dl=rm; if constexpr((MODE&M_WIN)!=0){ unset=!(rm>-INFINITY); dl=unset?0.f:rm; } mhat=fadd_s(mhat,dl); \
      _Pragma("unroll") for(int r=0;r<16;++r){P0[r]=fsub_s(P0[r],dl);P1[r]=fsub_s(P1[r],dl);} \
      _Pragma("unroll") for(int r=0;r<16;++r)negm[r]=-mhat; asm volatile("":"+v"(negm)); } \
    _Pragma("unroll") for(int r=0;r<16;++r)P0[r]=__builtin_amdgcn_exp2f(P0[r]); }while(0)
  #define RESC() do{ if(resc){ asm volatile("s_waitcnt lgkmcnt(0)":::"memory"); \
      _Pragma("unroll") for(int d_=0;d_<2;++d_) _Pragma("unroll") for(int r=0;r<16;++r)o[d_][r]*=wsf[crow(r,hi)]; } }while(0)
  f32x16 pA0,pA1,pB0,pB1;
  int sl_prev=0,sl_cur=0,sl_next=SLOTB;
  #define ROT() do{sl_prev=sl_cur;sl_cur=sl_next;sl_next=(sl_next==(NSLOT-1)*SLOTB)?0:sl_next+SLOTB;}while(0)
  DMA_K(2,2*SLOTB);
  WAIT_BAR(3);
  qkt(pA0,pA1,Kbase,qr,negm,r32,hi);asm volatile("s_nop 15\n\ts_nop 7":"+v"(pA0),"+v"(pA1));CMASK(pA0,pA1,0);
  START(pA0,pA1);
  _Pragma("unroll") for(int r=0;r<16;++r)pA1[r]=__builtin_amdgcn_exp2f(pA1[r]);
  WAIT_BAR(0);
  DMA_K(3,0);DMA_V(1,SLOTB);
  ROT();
  kload8(kf,kp0+sl_cur);
  WAIT_BAR(2);
  s16x4 vlo[8],vhi[8]; u32x4 pw0,pw1,pw2,pw3;
  #define PKW(P,B) cvtpk_s(P[B],P[B+1])
  #define PAF(k) __builtin_bit_cast(bf16x8,pw##k)
  #define VFR(i) (bf16x8){vlo[i][0],vlo[i][1],vlo[i][2],vlo[i][3],vhi[i][0],vhi[i][1],vhi[i][2],vhi[i][3]}
  #define PIN(x) asm volatile("":"+v"(x))
  #define MX3(a,b,c) __builtin_fmaxf(__builtin_fmaxf((a),(b)),(c))
  #define GAPA(MF,A0,A1,A2,A3,W0,W1,PW) do{ MF; sacc+=A0; sacc+=A1; sacc+=A2; sacc+=A3; PIN(sacc); W0; W1; PIN(PW); SBAR(); }while(0)
  #define EX(v) __builtin_amdgcn_exp2f(v)
  #define GAPB(MF,X,B) do{ MF; X[B]=EX(X[B]); X[B+1]=EX(X[B+1]); X[B+2]=EX(X[B+2]); X[B+3]=EX(X[B+3]); PIN(X); SBAR(); }while(0)
  #define VRD(i) do{ vlo[i]=vtr(vp_+(((i)>>2)*4096+((i)&3)*1024)); vhi[i]=vtr(vp_+(((i)>>2)*4096+((i)&3)*1024+512)); }while(0)
  #define KRD(G,j) do{ if(G){ kload2(kf,kp0+sl_next,j); SBAR(); } }while(0)
  #define STEP(C0,C1,P0,P1,t,GK,GV,GL) do{ SBAR(); \
    const lds_cptr vp_=vp0+sl_prev; \
    VRD(0); SBAR(); float sacc=(P0[0]+P0[1]); \
    GAPA(C0=__builtin_amdgcn_mfma_f32_32x32x16_bf16(kf[0],qr[0],negm,0,0,0), P0[2],P0[3],P0[4],P0[5],     pw0[0]=PKW(P0,0), pw0[1]=PKW(P0,2), pw0); \
    VRD(4); SBAR(); GAPA(C1=__builtin_amdgcn_mfma_f32_32x32x16_bf16(kf[1],qr[0],negm,0,0,0), P0[6],P0[7],P0[8],P0[9],     pw0[2]=PKW(P0,4), pw0[3]=PKW(P0,6), pw0); \
    VRD(1); SBAR(); GAPA(C0=__builtin_amdgcn_mfma_f32_32x32x16_bf16(kf[2],qr[1],C0,0,0,0),   P0[10],P0[11],P0[12],P0[13], pw1[0]=PKW(P0,8), pw1[1]=PKW(P0,10), pw1); \
    VRD(5); SBAR(); GAPA(C1=__builtin_amdgcn_mfma_f32_32x32x16_bf16(kf[3],qr[1],C1,0,0,0),   P0[14],P0[15],P1[0],P1[1],   pw1[2]=PKW(P0,12),pw1[3]=PKW(P0,14), pw1); \
    VRD(2); SBAR(); GAPA(C0=__builtin_amdgcn_mfma_f32_32x32x16_bf16(kf[4],qr[2],C0,0,0,0),   P1[2],P1[3],P1[4],P1[5],     pw2[0]=PKW(P1,0), pw2[1]=PKW(P1,2), pw2); \
    VRD(6); SBAR(); GAPA(C1=__builtin_amdgcn_mfma_f32_32x32x16_bf16(kf[5],qr[2],C1,0,0,0),   P1[6],P1[7],P1[8],P1[9],     pw2[2]=PKW(P1,4), pw2[3]=PKW(P1,6), pw2); \
    VRD(3); SBAR(); GAPA(C0=__builtin_amdgcn_mfma_f32_32x32x16_bf16(kf[6],qr[3],C0,0,0,0),   P1[10],P1[11],P1[12],P1[13], pw3[0]=PKW(P1,8), pw3[1]=PKW(P1,10), pw3); \
    VRD(7); SBAR(); GAPA(C1=__builtin_amdgcn_mfma_f32_32x32x16_bf16(kf[7],qr[3],C1,0,0,0),   P1[14],P1[15],0.f,0.f,       pw3[2]=PKW(P1,12),pw3[3]=PKW(P1,14), pw3); \
    l_reg+=sacc; \
    if(GK){DMA_K((t)+3,sl_cur);} if(GV){DMA_V((t)+1,sl_next);} \
    CMASK(C0,C1,t); \
    { float a=MX3(C0[0],C0[1],C1[0]),b=MX3(C0[2],C0[3],C1[1]); a=MX3(a,C1[2],C1[3]); \
      _Pragma("unroll") for(int r=4;r<16;r+=4){a=MX3(a,C0[r],C0[r+1]);b=MX3(b,C0[r+2],C0[r+3]);a=MX3(a,C1[r],C1[r+1]);b=MX3(b,C1[r+2],C1[r+3]);} \
      float rm=__builtin_fmaxf(a,b); { auto rr=__builtin_amdgcn_permlane32_swap(__float_as_uint(rm),__float_as_uint(rm),false,false); rm=__builtin_fmaxf(__uint_as_float(rr[0]),__uint_as_float(rr[1])); } \
      resc=false; bool fresh_=false; if constexpr((MODE&M_WIN)!=0) fresh_=unset&&(rm>-INFINITY); \
      if(__builtin_expect(__any((rm>(float)THRL)||fresh_),0)){ const float dl=fresh_?rm:__builtin_fmaxf(rm,0.f); mhat+=dl; if constexpr((MODE&M_WIN)!=0) unset=unset&&!fresh_; \
        _Pragma("unroll") for(int r=0;r<16;++r){C0[r]-=dl;C1[r]-=dl;} \
        _Pragma("unroll") for(int r=0;r<16;++r)negm[r]=-mhat; asm volatile("":"+v"(negm)); \
        const float f=fresh_?1.f:__builtin_amdgcn_exp2f(-dl); l_reg*=f; if(hi==0)wsf[r32]=f; resc=true; } } \
    SBAR(); \
    GAPB(o[0]=__builtin_amdgcn_mfma_f32_32x32x16_bf16(PAF(0),VFR(0),o[0],0,0,0), C0,0); \
    GAPB(o[1]=__builtin_amdgcn_mfma_f32_32x32x16_bf16(PAF(0),VFR(4),o[1],0,0,0), C0,4); \
    KRD(GL,0); GAPB(o[0]=__builtin_amdgcn_mfma_f32_32x32x16_bf16(PAF(1),VFR(1),o[0],0,0,0), C0,8); \
    KRD(GL,1); GAPB(o[1]=__builtin_amdgcn_mfma_f32_32x32x16_bf16(PAF(1),VFR(5),o[1],0,0,0), C0,12); \
    KRD(GL,2); GAPB(o[0]=__builtin_amdgcn_mfma_f32_32x32x16_bf16(PAF(2),VFR(2),o[0],0,0,0), C1,0); \
    KRD(GL,3); GAPB(o[1]=__builtin_amdgcn_mfma_f32_32x32x16_bf16(PAF(2),VFR(6),o[1],0,0,0), C1,4); \
    GAPB(o[0]=__builtin_amdgcn_mfma_f32_32x32x16_bf16(PAF(3),VFR(3),o[0],0,0,0), C1,8); \
    GAPB(o[1]=__builtin_amdgcn_mfma_f32_32x32x16_bf16(PAF(3),VFR(7),o[1],0,0,0), C1,12); \
    }while(0)
  int t=1;
  #undef CMASK
  #define CMASK(P0,P1,t) KBONLY(P0,P1,t)
  for(;t+7<NT;t+=2){
    STEP(pB0,pB1,pA0,pA1,t,true,true,true);     WAIT_BAR(2); RESC(); ROT();
    STEP(pA0,pA1,pB0,pB1,t+1,true,true,true);   WAIT_BAR(2); RESC(); ROT();
  }
  #undef CMASK
  #define CMASK(P0,P1,t) do{ if constexpr((MODE&M_KB)!=0) kbias(P0,P1,kbl+64*((t)+t_first),hi); fix_tile<MODE>(P0,P1,64*((t)+t_first)-q0,qrel,hi,dtl); }while(0)
  #define ENDW(tt) do{ if((tt)+3<NT){WAIT_BAR(2);} else if((tt)+2<NT){WAIT_BAR(1);} else {WAIT_BAR(0);} }while(0)
  for(;t+1<NT;t+=2){
    STEP(pB0,pB1,pA0,pA1,t,(t+3<NT),(t+1<NT),(t+1<NT));       ENDW(t);   RESC(); ROT();
    STEP(pA0,pA1,pB0,pB1,t+1,(t+4<NT),(t+2<NT),(t+2<NT));     ENDW(t+1); RESC(); ROT();
  }
  STEP(pB0,pB1,pA0,pA1,NT-1,false,false,false); RESC();
  { float sacc=pB0[0]+pB0[1]; _Pragma("unroll") for(int r=2;r<16;++r)sacc+=pB0[r]; _Pragma("unroll") for(int r=0;r<16;++r)sacc+=pB1[r]; l_reg+=sacc;
    pw0=(u32x4){PKW(pB0,0),PKW(pB0,2),PKW(pB0,4),PKW(pB0,6)};pw1=(u32x4){PKW(pB0,8),PKW(pB0,10),PKW(pB0,12),PKW(pB0,14)};pw2=(u32x4){PKW(pB1,0),PKW(pB1,2),PKW(pB1,4),PKW(pB1,6)};pw3=(u32x4){PKW(pB1,8),PKW(pB1,10),PKW(pB1,12),PKW(pB1,14)};
    SBAR(); pv(o,vb0+sl_cur,PAF(0),PAF(1),PAF(2),PAF(3)); }
  #undef PKW
  #undef PAF
  #undef VFR
  #undef PIN
  #undef MX3
  #undef GAPA
  #undef GAPB
  #undef EX
  #undef VRD
  #undef KRD
  #undef STEP
  #undef ENDW
  {auto rr=__builtin_amdgcn_permlane32_swap(__float_as_uint(l_reg),__float_as_uint(l_reg),false,false);l_reg=__uint_as_float(rr[0])+__uint_as_float(rr[1]);}
  if constexpr((MODE&M_WIN)!=0) l_reg+=exp2f(sink2-mhat);
  if(hi==0)wsf[32+r32]=l_reg;asm volatile("s_waitcnt lgkmcnt(0)":::"memory");
  float rli[16];
  #pragma unroll
  for(int r=0;r<16;++r)rli[r]=__builtin_amdgcn_rcpf(wsf[32+crow(r,hi)]);
  bf16*Ow=Og+(long)(q0+wid*QBLK)*opitch;
  { bf16*stg=(bf16*)(shm+LDS_OST)+wid*2048;
    #pragma unroll
    for(int r=0;r<16;++r){const int orow=crow(r,hi);
      #pragma unroll
      for(int d0=0;d0<2;++d0)stg[orow*64+d0*32+r32]=__float2bfloat16(o[d0][r]*rli[r]);}
    asm volatile("s_waitcnt lgkmcnt(0)":::"memory");
    #pragma unroll
    for(int i=0;i<4;++i){const int row=i*8+(lane>>3),ch=lane&7; const u32x4 v=*(const u32x4*)(stg+row*64+ch*8); ATTN_STORE16(Ow+(long)row*opitch+ch*8,v);} }
  asm volatile("s_waitcnt lgkmcnt(0)\n\ts_barrier":::"memory");
  #undef DMA_K
  #undef DMA_V
  #undef CMASK
  #undef KBONLY
  #undef START
  #undef RESC
  #undef ROT
}
constexpr int ATTN_LDS_BYTES=LDS_BYTES;
#undef SBAR
#undef WAIT_BAR
}
__device__ __forceinline__ int lane_id_opaque() { int l; asm volatile("v_mbcnt_lo_u32_b32 %0, -1, 0\n\tv_mbcnt_hi_u32_b32 %0, -1, %0" : "=v"(l)); return l; }
#define GAS __attribute__((address_space(1)))
#define LAS __attribute__((address_space(3)))
typedef unsigned short bf16;
typedef unsigned v4u __attribute__((ext_vector_type(4)));
typedef float f32x4 __attribute__((ext_vector_type(4)));
typedef short bf16x8 __attribute__((ext_vector_type(8)));
typedef GAS unsigned gu32;
typedef GAS unsigned long long gu64;
#define RLX_AGENT __ATOMIC_RELAXED, __HIP_MEMORY_SCOPE_AGENT
#define LDS_WAIT() asm volatile("s_waitcnt lgkmcnt(0)" ::: "memory")
#define VM_WAIT() asm volatile("s_waitcnt vmcnt(0)" ::: "memory")
__device__ __forceinline__ unsigned long long rt() { return __builtin_amdgcn_s_memrealtime(); }
__device__ __forceinline__ unsigned f2bf(float f) { unsigned u = __builtin_bit_cast(unsigned, f); return (u + 0x7fffu + ((u >> 16) & 1u)) >> 16; }
__device__ __forceinline__ unsigned pk2(float lo, float hi) { return f2bf(lo) | (f2bf(hi) << 16); }

#define XB_TMO      128
#define XB_XCNT(j)  (256  + 64 * (j))
#define XB_XSUB(j)  (1280 + 64 * (j))
#define XB_XGEN(j)  (2304 + 64 * (j))
#define XB_TOP      3328
#define XB_TOPGEN   3392
#define XCD_BAR_WORDS 3456
#define XB_SPIN_CAP (1u << 18)

__device__ __forceinline__ unsigned xb_ld(unsigned* p)              { return __hip_atomic_load(p, __ATOMIC_RELAXED, __HIP_MEMORY_SCOPE_AGENT); }
__device__ __forceinline__ unsigned xb_add(unsigned* p, unsigned v) { return __hip_atomic_fetch_add(p, v, __ATOMIC_RELAXED, __HIP_MEMORY_SCOPE_AGENT); }
__device__ __forceinline__ unsigned xb_xcc_id() { return (unsigned)__builtin_amdgcn_s_getreg((3 << 11) | 20) & 0xFu; }
#define XB_SPIN(cond, bar) do { unsigned _sp = 0; while (cond) { __builtin_amdgcn_s_sleep(1); \
    if ((++_sp & 255u) == 0u) { if (xb_ld(&(bar)[XB_TMO])) break; if (_sp > XB_SPIN_CAP) { atomicAdd(&(bar)[XB_TMO], 1u); break; } } } } while (0)

struct XcdBarrier {
    int wv;
    unsigned* bar; unsigned x;
    volatile LAS unsigned* st;
};

__device__ __forceinline__ XcdBarrier xcd_barrier_post(unsigned* bar, volatile LAS unsigned* st) {
    XcdBarrier b; b.bar = bar; b.x = xb_xcc_id(); b.st = st;
    if (threadIdx.x == 0) (void)xb_add(&bar[XB_XCNT(b.x)], 1u);
    return b;
}
__device__ __forceinline__ void xcd_barrier_complete(unsigned* bar, unsigned x, unsigned& nloc, unsigned& nx) {
    const unsigned G = gridDim.x * gridDim.y * gridDim.z;
    unsigned sum, cnt, mine, sp = 0u;
    for (;;) {
        sum = 0u; cnt = 0u; mine = 0u;
#pragma unroll
        for (unsigned j = 0; j < 16; ++j) { const unsigned c = xb_ld(&bar[XB_XCNT(j)]); sum += c; cnt += (c > 0u) ? 1u : 0u; mine = (j == x) ? c : mine; }
        if (sum == G) break;
        __builtin_amdgcn_s_sleep(1);
        if ((++sp & 255u) == 0u) { if (xb_ld(&bar[XB_TMO])) break; if (sp > XB_SPIN_CAP) { atomicAdd(&bar[XB_TMO], 1u); break; } }
    }
    nloc = mine > 0u ? mine : 1u; nx = cnt > 0u ? cnt : 1u;
}

__device__ __forceinline__ void xcd_barrier(const XcdBarrier& b) {
    asm volatile("s_waitcnt vmcnt(0)" ::: "memory");
    __syncthreads();
    if (b.wv == 0 && lane_id_opaque() == 0) {
        unsigned* bar = b.bar;
        __builtin_amdgcn_s_waitcnt(0);
        unsigned nloc = b.st[0], nx = b.st[1];
        if (nloc == 0u) { xcd_barrier_complete(bar, b.x, nloc, nx); b.st[0] = nloc; b.st[1] = nx; }
        const unsigned old = xb_add(&bar[XB_XSUB(b.x)], 1u);
        const unsigned gen = old / nloc;
        if (old + 1u == (gen + 1u) * nloc) {
            __builtin_amdgcn_fence(__ATOMIC_RELEASE, "agent");
            asm volatile("s_waitcnt vmcnt(0)" ::: "memory");
            const unsigned og = xb_add(&bar[XB_TOP], 1u);
            const unsigned tg = og / nx;
            if (og + 1u == (tg + 1u) * nx) xb_add(&bar[XB_TOPGEN], 1u);
            else XB_SPIN(xb_ld(&bar[XB_TOPGEN]) == tg, bar);
            __builtin_amdgcn_fence(__ATOMIC_ACQUIRE, "agent");
            xb_add(&bar[XB_XGEN(b.x)], 1u);
            asm volatile("s_waitcnt vmcnt(0)" ::: "memory");
        } else {
            XB_SPIN(xb_ld(&bar[XB_XGEN(b.x)]) == gen, bar);
            __builtin_amdgcn_fence(__ATOMIC_ACQUIRE, "agent");
            asm volatile("s_waitcnt vmcnt(0)" ::: "memory");
        }
    }
    __syncthreads();
}

constexpr int NWAVES = 8;
constexpr int NB = 4, SEQ = 2048, TOK = NB * SEQ, DM = 2048, NPROJ = 4608, INW = 4360, PLED = 256;
constexpr int NEXP = 16, DEXP = 512, SLOTS = 20480, MAXRT = SLOTS / 256;
constexpr int PC_FQ = 0, PC_FK = 512, PC_FV = 1024, PC_DQ = 1536, PC_DK = 2048, PC_DV = 2560, PC_PU = 3072, PC_SQ = 3584, PC_SK = 4096, PC_SV = 4224, PC_FF = 4352;
constexpr float LOG2E = 1.4426950408889634f;
constexpr float C2 = 0.125f * LOG2E;
constexpr float ALPHA = 1.4142135623730951f;
constexpr float LN_EPS = 1e-5f;
#ifndef SLOWREF_
#define SLOWREF_ 0
#endif
constexpr int NPH = 12;
#ifndef FASTMIX_
#define FASTMIX_ 1
#endif
constexpr bool FASTMIX = FASTMIX_ != 0;
#ifndef FASTMASK_
#define FASTMASK_ 15
#endif
constexpr int FASTMASK = FASTMIX ? FASTMASK_ : 0;

enum { I_X = 0, I_P, I_REL, I_WIN, I_BF, I_LQ1, I_LK1, I_LQ2, I_LK2, I_DNG, I_POOLW, I_POOLS, I_SINK, I_WO, I_LN1G, I_LN1B, I_RGW, I_RGB, I_REW, I_REB, I_WGATE, I_WUP, I_WDOWN, I_PGW, I_PUW, I_LN2G, I_LN2B, N_IN };

constexpr size_t MiB = 1u << 20;
constexpr size_t WS_CTL = 0, CTL_ZERO_BYTES = 1 * MiB;
constexpr size_t WS_KB2 = 1 * MiB;
constexpr size_t WS_TBL = 1 * MiB + 512 * 1024;
constexpr size_t WS_WRT0 = 2 * MiB;
constexpr size_t WS_LTOK = 3 * MiB;
constexpr size_t WS_LW = 3 * MiB + 512 * 1024;
constexpr size_t WS_TOKE = 4 * MiB;
constexpr size_t WS_TOKP = 4 * MiB + 128 * 1024;
constexpr size_t WS_PT0 = 5 * MiB;
constexpr size_t WL = 131 * MiB;
constexpr size_t WS_WIN0 = 6 * MiB, WS_WO0 = 24 * MiB, WS_W10 = 32 * MiB, WS_WD0 = 96 * MiB, WS_WG0 = 128 * MiB, WS_WU0 = 136 * MiB;
constexpr size_t WS_XB = 268 * MiB, WS_PB0 = 300 * MiB;
constexpr size_t WS_A = 308 * MiB;
constexpr size_t WS_U = 388 * MiB;
constexpr size_t WS_C = 420 * MiB;
constexpr size_t WS_DSCR = 452 * MiB;
constexpr size_t WS_PLE = 452 * MiB;
constexpr size_t WS_H = 484 * MiB, WS_HB = 548 * MiB, WS_END = 580 * MiB;
#define WS_WIN (WS_WIN0 + (size_t)l * WL)
#define WS_WO (WS_WO0 + (size_t)l * WL)
#define WS_W1 (WS_W10 + (size_t)l * WL)
#define WS_WD (WS_WD0 + (size_t)l * WL)
#define WS_WG (WS_WG0 + (size_t)l * WL)
#define WS_WU (WS_WU0 + (size_t)l * WL)
#define WS_WRT (WS_WRT0 + (size_t)l * 262144)
#define WS_PT (WS_PT0 + (size_t)l * 131072)
#define WS_PB (WS_PB0 + (size_t)l * 4 * MiB)
constexpr int CW_BAR = 4096;
constexpr int CW_CONV = 8192;
constexpr int CW_QUE = 12288;
constexpr int CW_CNT = 16384;

constexpr int RING_OFF = 0, RING_BYTES = 131072;
constexpr int LDSCTL_OFF = RING_BYTES, MISC_OFF = LDSCTL_OFF + 320;
constexpr int TAB_OFF = LDSCTL_OFF + 1024;
constexpr int LDS_BYTES = 147456;

static __device__ const unsigned char T5BUCKET[129] = {0, 1, 2, 3, 4, 5, 6, 7, 8, 9, 10, 11, 12, 13, 14, 15, 16, 16, 16, 17, 17, 18, 18, 18, 19, 19, 19, 20, 20, 20, 20, 21, 21, 21, 21, 22, 22, 22, 22, 22, 23, 23, 23, 23, 23, 23, 24, 24, 24, 24, 24, 24, 25, 25, 25, 25, 25, 25, 25, 26, 26, 26, 26, 26, 26, 26, 26, 27, 27, 27, 27, 27, 27, 27, 27, 27, 27, 28, 28, 28, 28, 28, 28, 28, 28, 28, 28, 29, 29, 29, 29, 29, 29, 29, 29, 29, 29, 29, 29, 30, 30, 30, 30, 30, 30, 30, 30, 30, 30, 30, 30, 30, 30, 31, 31, 31, 31, 31, 31, 31, 31, 31, 31, 31, 31, 31, 31, 31, 31};

struct Args { const float* in[N_IN]; float* out; unsigned char* ws; int ph_lo, ph_hi; unsigned long long seq0, seq1, seq2, seq3; };

struct Ctx {
    LAS unsigned char* lds; int tid, lane, wave, vcu, G, gw, NGW;
    unsigned char* ws; float* out;
};

__device__ __forceinline__ float wave_sum(float v) {
#pragma unroll
    for (int o = 1; o < 64; o <<= 1) v += __shfl_xor(v, o);
    return v;
}
__device__ __forceinline__ float wave_max(float v) {
#pragma unroll
    for (int o = 1; o < 64; o <<= 1) v = fmaxf(v, __shfl_xor(v, o));
    return v;
}
__device__ __forceinline__ float bf2f(unsigned short b) { return __builtin_bit_cast(float, (unsigned)b << 16); }
__device__ __forceinline__ float bflo(unsigned w) { return __builtin_bit_cast(float, w << 16); }
__device__ __forceinline__ float bfhi(unsigned w) { return __builtin_bit_cast(float, w & 0xffff0000u); }

namespace pg8 {
struct EpiStore {
    static constexpr bool PERM = true, AFTER_DRAIN = false;
    bf16_t* O; int ldc; int pn_mask;
    __device__ __forceinline__ void operator()(const f32x4 (&acc)[2][2][4][2], const Unit& u, int wr, int wc, int fr, int fq) const {
        const int row0 = u.pm * BM + wr * 64 + fr; const int col0 = (u.pn & pn_mask) * BM + wc * 32 + 8 * fq;
#pragma unroll
        for (int ai = 0; ai < 2; ++ai)
#pragma unroll
            for (int m = 0; m < 4; ++m) { bf16_t* rowp = O + (size_t)(row0 + ai * HALF + m * 16) * ldc + col0;
#pragma unroll
                for (int bj = 0; bj < 2; ++bj) { const f32x4 v0 = acc[ai][bj][m][0], v1 = acc[ai][bj][m][1];
                    u32x4 w; w.x = cvt_pk_bf16(v0[0], v0[1]); w.y = cvt_pk_bf16(v0[2], v0[3]); w.z = cvt_pk_bf16(v1[0], v1[1]); w.w = cvt_pk_bf16(v1[2], v1[3]);
                    *(u32x4*)(rowp + bj * HALF) = w; } }
    }
};
struct EpiResF32 {
    static constexpr bool PERM = false, AFTER_DRAIN = false;
    const float* res; float* out; int ldc; float alpha;
    __device__ __forceinline__ void operator()(const f32x4 (&acc)[2][2][4][2], const Unit& u, int wr, int wc, int fr, int fq) const {
        const int col0 = u.pn * BM + wc * 32 + 4 * fq;
#pragma unroll
        for (int ai = 0; ai < 2; ++ai)
#pragma unroll
            for (int m = 0; m < 4; ++m) { const size_t off = (size_t)(u.pm * BM + ai * HALF + wr * 64 + m * 16 + fr) * ldc + col0;
#pragma unroll
                for (int bj = 0; bj < 2; ++bj)
#pragma unroll
                    for (int n = 0; n < 2; ++n) { const f32x4 rs = *(const f32x4*)(res + off + bj * HALF + n * 16); *(f32x4*)(out + off + bj * HALF + n * 16) = acc[ai][bj][m][n] + rs * alpha; } }
    }
};
struct EpiSwiglu {
    static constexpr bool PERM = true, AFTER_DRAIN = false;
    bf16_t* hid; const float* lw; const int* cnt; const __attribute__((address_space(3))) int* ts;
    __device__ __forceinline__ void operator()(const f32x4 (&acc)[2][2][4][2], const Unit& u, int wr, int wc, int fr, int fq) const {
        const int e = u.pn >> 2, j = u.pn & 3; const int pos0 = (u.pm - ts[e]) * BM, ne = cnt[64 * e];
        const int col0 = j * 128 + wc * 32 + 8 * fq;
#pragma unroll
        for (int ai = 0; ai < 2; ++ai)
#pragma unroll
            for (int m = 0; m < 4; ++m) { const int rl = ai * HALF + wr * 64 + m * 16 + fr; const int pos = pos0 + rl;
                const float w = pos < ne ? lw[e * 8192 + pos] : 0.f;
                float r[8];
#pragma unroll
                for (int n = 0; n < 2; ++n)
#pragma unroll
                    for (int i = 0; i < 4; ++i) { const float a = acc[ai][0][m][n][i], up = acc[ai][1][m][n][i]; r[n * 4 + i] = a / (1.f + __expf(-a)) * up * w; }
                u32x4 o; o.x = cvt_pk_bf16(r[0], r[1]); o.y = cvt_pk_bf16(r[2], r[3]); o.z = cvt_pk_bf16(r[4], r[5]); o.w = cvt_pk_bf16(r[6], r[7]);
                *(u32x4*)(hid + (size_t)(u.pm * BM + rl) * 512 + col0) = o; }
    }
};
struct EpiPle {
    static constexpr bool PERM = true, AFTER_DRAIN = false;
    const bf16_t* U; bf16_t* O; int ldc;
    __device__ __forceinline__ void operator()(const f32x4 (&acc)[2][2][4][2], const Unit& u, int wr, int wc, int fr, int fq) const {
        const int row0 = u.pm * BM + wr * 64 + fr; const int col0 = u.pn * BM + wc * 32 + 8 * fq;
#pragma unroll
        for (int ai = 0; ai < 2; ++ai)
#pragma unroll
            for (int m = 0; m < 4; ++m) { const size_t off = (size_t)(row0 + ai * HALF + m * 16) * ldc + col0;
#pragma unroll
                for (int bj = 0; bj < 2; ++bj) { const u32x4 uu = *(const u32x4*)(U + off + bj * HALF); const f32x4 v0 = acc[ai][bj][m][0], v1 = acc[ai][bj][m][1];
                    float r[8];
                    r[0] = __builtin_bit_cast(float, uu.x << 16) / (1.f + __expf(-v0[0])); r[1] = __builtin_bit_cast(float, uu.x & 0xffff0000u) / (1.f + __expf(-v0[1]));
                    r[2] = __builtin_bit_cast(float, uu.y << 16) / (1.f + __expf(-v0[2])); r[3] = __builtin_bit_cast(float, uu.y & 0xffff0000u) / (1.f + __expf(-v0[3]));
                    r[4] = __builtin_bit_cast(float, uu.z << 16) / (1.f + __expf(-v1[0])); r[5] = __builtin_bit_cast(float, uu.z & 0xffff0000u) / (1.f + __expf(-v1[1]));
                    r[6] = __builtin_bit_cast(float, uu.w << 16) / (1.f + __expf(-v1[2])); r[7] = __builtin_bit_cast(float, uu.w & 0xffff0000u) / (1.f + __expf(-v1[3]));
                    u32x4 o; o.x = cvt_pk_bf16(r[0], r[1]); o.y = cvt_pk_bf16(r[2], r[3]); o.z = cvt_pk_bf16(r[4], r[5]); o.w = cvt_pk_bf16(r[6], r[7]);
                    *(u32x4*)(O + off + bj * HALF) = o; } }
    }
};
struct MoeOrder {
    const __attribute__((address_space(3))) int* ts; int ncol, G, c;
    __device__ __forceinline__ bool next(int i, Unit& u) const {
        const int nrt = ts[16]; const int L = i * G + c; if (L >= nrt * ncol) return false;
        const int rt = L / ncol, ct = L - rt * ncol; int e = 0;
#pragma unroll
        for (int j = 1; j < 16; ++j) e += (ts[j] <= rt) ? 1 : 0;
        u.pm = __builtin_amdgcn_readfirstlane(rt); u.pn = __builtin_amdgcn_readfirstlane(e * ncol + ct); return true;
    }
    __device__ __forceinline__ void a_ready(const Unit&) const {}
    __device__ __forceinline__ void done(const Unit&) const {}
};
}

__device__ __forceinline__ void transpose_item(const float* src, int src_ld, int src_col0, int ncols, int k0, bf16* dst, int dst_K, int dst_row0, float scale, int lane) {
    const int c4 = 4 * (lane & 15), kq = 16 * (lane >> 4);
    f32x4 v[16];
    if (c4 < ncols) {
#pragma unroll
        for (int i = 0; i < 16; ++i) v[i] = *(const GAS f32x4*)(src + (size_t)(k0 + kq + i) * src_ld + src_col0 + c4);
    } else {
#pragma unroll
        for (int i = 0; i < 16; ++i) v[i] = (f32x4){0.f, 0.f, 0.f, 0.f};
    }
#pragma unroll
    for (int c = 0; c < 4; ++c)
#pragma unroll
        for (int h = 0; h < 2; ++h) { v4u o;
            o.x = pk2(v[8 * h + 0][c] * scale, v[8 * h + 1][c] * scale); o.y = pk2(v[8 * h + 2][c] * scale, v[8 * h + 3][c] * scale);
            o.z = pk2(v[8 * h + 4][c] * scale, v[8 * h + 5][c] * scale); o.w = pk2(v[8 * h + 6][c] * scale, v[8 * h + 7][c] * scale);
            *(GAS v4u*)(dst + (size_t)(dst_row0 + c4 + c) * dst_K + k0 + kq + 8 * h) = o; }
}

enum { CK_WIN = 0, CK_PT, CK_WU, CK_WO, CK_W1, CK_WD, CK_WG };
constexpr int CN_WIN = 32 * 72, CN_PT = 16, CN_WU = 4 * 32, CN_WO = 32 * 32, CN_W1 = 16 * 32 * 16, CN_WD = 16 * 8 * 32, CN_WG = 32 * 32;
constexpr int NSEG = 14;
constexpr int SEG0 = 0, SEG1 = SEG0 + CN_WIN, SEG2 = SEG1 + CN_PT, SEG3 = SEG2 + CN_WU, SEG4 = SEG3 + CN_PT, SEG5 = SEG4 + CN_WU, SEG6 = SEG5 + CN_WO, SEG7 = SEG6 + CN_W1,
              SEG8 = SEG7 + CN_WD, SEG9 = SEG8 + CN_WG, SEG10 = SEG9 + CN_WIN, SEG11 = SEG10 + CN_WO, SEG12 = SEG11 + CN_W1, SEG13 = SEG12 + CN_WD, SEG14 = SEG13 + CN_WG;
constexpr int SLOT_LO[5] = {SEG0, SEG5, SEG7, SEG11, SEG12}, SLOT_HI[5] = {SEG5, SEG7, SEG11, SEG12, SEG14};
__device__ __forceinline__ void conv_item(const Args& A, unsigned char* ws, int gi, int lane) {
    int kind, l, r;
    if (gi < SEG1) { kind = CK_WIN; l = 0; r = gi - SEG0; } else if (gi < SEG2) { kind = CK_PT; l = 0; r = gi - SEG1; } else if (gi < SEG3) { kind = CK_WU; l = 0; r = gi - SEG2; }
    else if (gi < SEG4) { kind = CK_PT; l = 1; r = gi - SEG3; } else if (gi < SEG5) { kind = CK_WU; l = 1; r = gi - SEG4; } else if (gi < SEG6) { kind = CK_WO; l = 0; r = gi - SEG5; }
    else if (gi < SEG7) { kind = CK_W1; l = 0; r = gi - SEG6; } else if (gi < SEG8) { kind = CK_WD; l = 0; r = gi - SEG7; } else if (gi < SEG9) { kind = CK_WG; l = 0; r = gi - SEG8; }
    else if (gi < SEG10) { kind = CK_WIN; l = 1; r = gi - SEG9; } else if (gi < SEG11) { kind = CK_WO; l = 1; r = gi - SEG10; } else if (gi < SEG12) { kind = CK_W1; l = 1; r = gi - SEG11; }
    else if (gi < SEG13) { kind = CK_WD; l = 1; r = gi - SEG12; } else { kind = CK_WG; l = 1; r = gi - SEG13; }
    if (kind == CK_WIN) { const int kb = r / 72, db = r % 72, d0 = db * 64; int sc0, nc;
        if (d0 < 1536) { sc0 = d0; nc = 64; } else if (d0 < 4352) { sc0 = d0 + 8; nc = 64; } else if (d0 == 4352) { sc0 = 1536; nc = 8; } else { sc0 = 0; nc = 0; }
        const bool isq = (d0 < 512) || (d0 >= PC_DQ && d0 < PC_DK) || (d0 >= PC_SQ && d0 < PC_SK);
        transpose_item(A.in[I_WIN] + (size_t)l * DM * INW, INW, sc0, nc, kb * 64, (bf16*)(ws + WS_WIN), DM, d0, isq ? C2 : 1.f, lane); }
    else if (kind == CK_WO) { const int kb = r >> 5, db = r & 31; transpose_item(A.in[I_WO] + (size_t)l * DM * DM, DM, db * 64, 64, kb * 64, (bf16*)(ws + WS_WO), DM, db * 64, 1.f, lane); }
    else if (kind == CK_W1) { const int e = r >> 9, kb = (r >> 4) & 31, db = r & 15; const int j = db >> 2, within = (db & 3) * 64;
        const float* src = (within < 128 ? A.in[I_WGATE] : A.in[I_WUP]) + (size_t)(l * NEXP + e) * DM * DEXP; const int col = 128 * j + (within & 127);
        transpose_item(src, DEXP, col, 64, kb * 64, (bf16*)(ws + WS_W1) + (size_t)e * 1024 * DM, DM, db * 64, 1.f, lane); }
    else if (kind == CK_WD) { const int e = r >> 8, kb = (r >> 5) & 7, db = r & 31;
        transpose_item(A.in[I_WDOWN] + (size_t)(l * NEXP + e) * DEXP * DM, DM, db * 64, 64, kb * 64, (bf16*)(ws + WS_WD) + (size_t)e * DM * DEXP, DEXP, db * 64, 1.f, lane); }
    else if (kind == CK_WG) { const int kb = r >> 5, db = r & 31; transpose_item(A.in[I_PGW] + (size_t)l * DM * DM, DM, db * 64, 64, kb * 64, (bf16*)(ws + WS_WG), DM, db * 64, 1.f, lane); }
    else if (kind == CK_WU) { const int kb = r >> 5, db = r & 31; transpose_item(A.in[I_PUW] + (size_t)l * PLED * DM, DM, db * 64, 64, kb * 64, (bf16*)(ws + WS_WU), PLED, db * 64, 1.f, lane); }
    else { const int g = r >> 2, kb = (r >> 1) & 1, db = r & 1; transpose_item(A.in[I_POOLW] + (size_t)(l * 4 + g) * 16384, 128, db * 64, 64, kb * 64, (bf16*)(ws + WS_PT) + g * 16384, 128, db * 64, 1.f, lane); }
}
__device__ __forceinline__ void conv_drain(const Ctx& C0, const Args& A, int slot) {
    const int lane = lane_id_opaque(); const int wave = C0.wave; unsigned char* ws = C0.ws;
    unsigned* q = (unsigned*)(ws + WS_CTL) + CW_CONV + 64 * slot; volatile LAS unsigned* qw = (volatile LAS unsigned*)(C0.lds + TAB_OFF + 132);
    const int lo = SLOT_LO[slot], hi = SLOT_HI[slot];
    for (;;) {
        __syncthreads();
        if (wave == 0 && lane == 0) qw[0] = atomicAdd(q, 64u);
        __syncthreads();
        const int base = lo + (int)__builtin_amdgcn_readfirstlane(qw[0]);
        if (base >= hi) break;
#pragma unroll 1
        for (int i = wave; i < 64; i += NWAVES) { const int gi = base + i; if (gi < hi) conv_item(A, ws, gi, lane); }
    }
}
__device__ __forceinline__ void ph_prologue(const Ctx& C0, const Args& A) {
    conv_drain(C0, A, 0);
    Ctx C = C0; C.lane = lane_id_opaque(); C.tid = C.wave * 64 + C.lane;
    unsigned char* ws = C.ws;
    const int gt = C.vcu * 512 + C.tid, NT = C.G * 512;
    {
        const GAS f32x4* x4 = (const GAS f32x4*)A.in[I_X]; GAS v4u* o = (GAS v4u*)(ws + WS_XB);
        for (int i = gt; i < TOK * DM / 8; i += NT) { const f32x4 a = x4[2 * i], b = x4[2 * i + 1]; v4u w; w.x = pk2(a.x, a.y); w.y = pk2(a.z, a.w); w.z = pk2(b.x, b.y); w.w = pk2(b.z, b.w); o[i] = w; }
    }
    {
        const GAS f32x4* p4 = (const GAS f32x4*)A.in[I_P]; GAS v4u* o = (GAS v4u*)(ws + WS_PB0);
        for (int i = gt; i < 2 * TOK * PLED / 8; i += NT) { const f32x4 a = p4[2 * i], b = p4[2 * i + 1]; v4u w; w.x = pk2(a.x, a.y); w.y = pk2(a.z, a.w); w.z = pk2(b.x, b.y); w.w = pk2(b.z, b.w); o[i] = w; }
    }
    {
        float* tbl = (float*)(ws + WS_TBL);
        for (int i = gt; i < 12 * 129; i += NT) { const int h = i / 129, d = i % 129; tbl[i] = A.in[I_REL][(int)T5BUCKET[d] * 12 + h] * LOG2E; }
        for (int i = gt; i < 2 * 20 * DM; i += NT) { const int l = i / (20 * DM), ii = i % (20 * DM), j = ii / DM, k = ii % DM; float* wrt = (float*)(ws + WS_WRT);
            wrt[ii] = j < 4 ? A.in[I_RGW][((size_t)l * DM + k) * 4 + j] : A.in[I_REW][((size_t)l * DM + k) * 16 + (j - 4)]; }
    }
}

#if SLOWREF_
__device__ __forceinline__ float slow_attn_row(const bf16* proj, int qcol, int kcol, int vcol, int b, int t, int window, const float* kb2, const float* dt, bool has_sink, float sink2, int lane) {
    const bf16* base = proj + (size_t)b * SEQ * NPROJ;
    float q[64];
    { const v4u* qp = (const v4u*)(base + (size_t)t * NPROJ + qcol);
#pragma unroll
      for (int i = 0; i < 8; ++i) { const v4u w = qp[i]; q[8 * i + 0] = bflo(w.x); q[8 * i + 1] = bfhi(w.x); q[8 * i + 2] = bflo(w.y); q[8 * i + 3] = bfhi(w.y); q[8 * i + 4] = bflo(w.z); q[8 * i + 5] = bfhi(w.z); q[8 * i + 6] = bflo(w.w); q[8 * i + 7] = bfhi(w.w); } }
    const int lo = window ? (t - window + 1 > 0 ? t - window + 1 : 0) : 0;
    float mx = -INFINITY;
    for (int s = lo + lane; s <= t; s += 64) {
        const v4u* kp = (const v4u*)(base + (size_t)s * NPROJ + kcol); float d = 0.f;
#pragma unroll
        for (int i = 0; i < 8; ++i) { const v4u w = kp[i]; d += q[8 * i + 0] * bflo(w.x) + q[8 * i + 1] * bfhi(w.x) + q[8 * i + 2] * bflo(w.y) + q[8 * i + 3] * bfhi(w.y) + q[8 * i + 4] * bflo(w.z) + q[8 * i + 5] * bfhi(w.z) + q[8 * i + 6] * bflo(w.w) + q[8 * i + 7] * bfhi(w.w); }
        if (kb2) d += kb2[s];
        if (dt) { const int dd = t - s; d += dt[dd < 128 ? dd : 128]; }
        mx = fmaxf(mx, d);
    }
    mx = wave_max(mx); if (has_sink) mx = fmaxf(mx, sink2);
    float l = 0.f; float o[64];
#pragma unroll
    for (int i = 0; i < 64; ++i) o[i] = 0.f;
    for (int s = lo + lane; s <= t; s += 64) {
        const v4u* kp = (const v4u*)(base + (size_t)s * NPROJ + kcol); float d = 0.f;
#pragma unroll
        for (int i = 0; i < 8; ++i) { const v4u w = kp[i]; d += q[8 * i + 0] * bflo(w.x) + q[8 * i + 1] * bfhi(w.x) + q[8 * i + 2] * bflo(w.y) + q[8 * i + 3] * bfhi(w.y) + q[8 * i + 4] * bflo(w.z) + q[8 * i + 5] * bfhi(w.z) + q[8 * i + 6] * bflo(w.w) + q[8 * i + 7] * bfhi(w.w); }
        if (kb2) d += kb2[s];
        if (dt) { const int dd = t - s; d += dt[dd < 128 ? dd : 128]; }
        const float p = exp2f(d - mx); l += p;
        const v4u* vp = (const v4u*)(base + (size_t)s * NPROJ + vcol);
#pragma unroll
        for (int i = 0; i < 8; ++i) { const v4u w = vp[i]; o[8 * i + 0] += p * bflo(w.x); o[8 * i + 1] += p * bfhi(w.x); o[8 * i + 2] += p * bflo(w.y); o[8 * i + 3] += p * bfhi(w.y); o[8 * i + 4] += p * bflo(w.z); o[8 * i + 5] += p * bfhi(w.z); o[8 * i + 6] += p * bflo(w.w); o[8 * i + 7] += p * bfhi(w.w); }
    }
    l = wave_sum(l); if (has_sink) l += exp2f(sink2 - mx);
#pragma unroll
    for (int st = 0; st < 6; ++st) { const int off = 32 >> st, n = 32 >> st; const bool up = (lane & off) != 0;
#pragma unroll
        for (int i = 0; i < n; ++i) { const float a = o[i], bb = o[i + n]; const float keep = up ? bb : a, send = up ? a : bb; o[i] = keep + __shfl_xor(send, off); } }
    return o[0] / l;
}

__device__ __forceinline__ void ph_mix_a(const Ctx& C, const Args& A, int l) {
    unsigned char* ws = C.ws; const bf16* proj = (const bf16*)(ws + WS_A); bf16* mix = (bf16*)(ws + WS_C); float* dscr = (float*)(ws + WS_DSCR);
    float* kb2 = (float*)(ws + WS_KB2); const float* tbl = (const float*)(ws + WS_TBL);
    const int lane = C.lane;
    if (!(FASTMASK & 1)) for (int u = C.gw; u < NB * 8; u += C.NGW) { const int b = u >> 3, h = u & 7; const float bf = A.in[I_BF][l * 8 + h];
        float v[32]; float run = 0.f;
#pragma unroll
        for (int i = 0; i < 32; ++i) { const int s = lane * 32 + i; const float f = bf2f(proj[(size_t)(b * SEQ + s) * NPROJ + PC_FF + h]) + bf;
            const float ls = fminf(f, 0.f) - log1pf(expf(-fabsf(f))); run += ls; v[i] = run; }
        float inc = run;
#pragma unroll
        for (int o = 1; o < 64; o <<= 1) { const float t = __shfl_up(inc, o); if (lane >= o) inc += t; }
        const float excl = inc - run;
#pragma unroll
        for (int i = 0; i < 32; ++i) kb2[(size_t)u * SEQ + lane * 32 + i] = -(excl + v[i]) * LOG2E;
    }
    if (!(FASTMASK & 8)) { LAS float* pw = (LAS float*)(C.lds + RING_OFF + C.wave * 16384);
      const float* W = A.in[I_POOLW] + (size_t)l * 4 * 128 * 128; const float* sc = A.in[I_POOLS] + l * 512;
      for (int t = C.gw; t < TOK; t += C.NGW) { const int tt = t & (SEQ - 1);
#pragma unroll
        for (int i = 0; i < 8; ++i) { const int c = lane + 64 * i, g = c >> 7, w = 2 << g; const int n = tt + 1 < w ? tt + 1 : w; float s = 0.f;
            for (int k = 0; k < n; ++k) s += bf2f(proj[(size_t)(t - k) * NPROJ + PC_PU + c]);
            pw[c] = s / (float)n - bf2f(proj[(size_t)t * NPROJ + PC_PU + c]); }
        LDS_WAIT(); asm volatile("" ::: "memory");
#pragma unroll
        for (int g = 0; g < 4; ++g) { float a0 = 0.f, a1 = 0.f; const float* Wg = W + g * 128 * 128;
            for (int c = 0; c < 128; ++c) { const float pv = pw[g * 128 + c]; a0 += pv * Wg[c * 128 + lane]; a1 += pv * Wg[c * 128 + lane + 64]; }
            mix[(size_t)t * DM + 1024 + g * 128 + lane] = (bf16)f2bf(a0 * sc[g * 128 + lane]); mix[(size_t)t * DM + 1024 + g * 128 + lane + 64] = (bf16)f2bf(a1 * sc[g * 128 + lane + 64]); }
        LDS_WAIT(); asm volatile("" ::: "memory");
      } }
    if (!(FASTMASK & 4)) for (int u = C.gw; u < 8 * TOK; u += C.NGW) { const int h = u / TOK, t = u % TOK, b = t / SEQ, tt = t % SEQ;
        const float r = slow_attn_row(proj, PC_SQ + h * 64, PC_SK + (h >> 2) * 64, PC_SV + (h >> 2) * 64, b, tt, 128, nullptr, tbl + (4 + h) * 129, true, A.in[I_SINK][l * 8 + h] * LOG2E, lane);
        mix[(size_t)t * DM + 1536 + h * 64 + lane] = (bf16)f2bf(r); }
    if (!(FASTMASK & 2)) for (int u = C.gw; u < 16 * TOK; u += C.NGW) { const int hh = u / TOK, t = u % TOK, b = t / SEQ, tt = t % SEQ; const int h = hh >> 2, m = (hh >> 1) & 1, half = hh & 1;
        const float r = slow_attn_row(proj, PC_DQ + (h * 2 + m) * 64, PC_DK + (h * 2 + m) * 64, PC_DV + h * 128 + half * 64, b, tt, 0, nullptr, tbl + h * 129, false, 0.f, lane);
        dscr[((size_t)t * 2 + m) * 512 + h * 128 + half * 64 + lane] = r; }
}
__device__ __forceinline__ void ph_mix_b(const Ctx& C, const Args& A, int l) {
    unsigned char* ws = C.ws; const bf16* proj = (const bf16*)(ws + WS_A); bf16* mix = (bf16*)(ws + WS_C); const float* dscr = (const float*)(ws + WS_DSCR);
    const float* kb2 = (const float*)(ws + WS_KB2); const int lane = C.lane;
    if (!(FASTMASK & 1)) for (int u = C.gw; u < 8 * TOK; u += C.NGW) { const int h = u / TOK, t = u % TOK, b = t / SEQ, tt = t % SEQ;
        const float r = slow_attn_row(proj, PC_FQ + h * 64, PC_FK + h * 64, PC_FV + h * 64, b, tt, 0, kb2 + (size_t)(b * 8 + h) * SEQ, nullptr, false, 0.f, lane);
        mix[(size_t)t * DM + h * 64 + lane] = (bf16)f2bf(r); }
    const float lam_init = (l == 0) ? 0.2f : 0.35550907f;
    const float s1 = wave_sum(A.in[I_LQ1][l * 64 + lane] * A.in[I_LK1][l * 64 + lane]), s2 = wave_sum(A.in[I_LQ2][l * 64 + lane] * A.in[I_LK2][l * 64 + lane]);
    const float lam = expf(s1) - expf(s2) + lam_init;
    const float g0 = A.in[I_DNG][l * 128 + lane], g1 = A.in[I_DNG][l * 128 + 64 + lane];
    if (!(FASTMASK & 2)) for (int u = C.gw; u < 4 * TOK; u += C.NGW) { const int h = u & 3, t = u >> 2;
        const float* o0 = dscr + ((size_t)t * 2 + 0) * 512 + h * 128; const float* o1 = dscr + ((size_t)t * 2 + 1) * 512 + h * 128;
        const float d0 = o0[lane] - lam * o1[lane], d1 = o0[lane + 64] - lam * o1[lane + 64];
        const float ms = wave_sum(d0 * d0 + d1 * d1) * (1.f / 128.f); const float r = 1.f / sqrtf(ms + LN_EPS) * (1.f - lam_init);
        mix[(size_t)t * DM + 512 + h * 128 + lane] = (bf16)f2bf(d0 * r * g0); mix[(size_t)t * DM + 512 + h * 128 + 64 + lane] = (bf16)f2bf(d1 * r * g1); }
}


#endif
constexpr int MX_KBL = 86016, MX_DTL = 94208, MX_WSUM = 95232;
constexpr int MX_NUNITS = 768 + 256 + 128;
__device__ __forceinline__ void fox_scan(const Ctx& C, const bf16* proj, int b, int h, int n, float bfv) {
    LAS float* kbl = (LAS float*)(C.lds + MX_KBL); LAS float* wsum = (LAS float*)(C.lds + MX_WSUM);
    const int s0 = 4 * C.tid; const bool act = s0 < n; float c[4]; float run = 0.f;
#pragma unroll
    for (int k = 0; k < 4; ++k) { float ls = 0.f; if (act) { const float f = bf2f(proj[(size_t)(b * SEQ + s0 + k) * NPROJ + PC_FF + h]) + bfv; ls = fminf(f, 0.f) - __logf(1.f + __expf(-fabsf(f))); } run += ls; c[k] = run; }
    float inc = run;
#pragma unroll
    for (int o = 1; o < 64; o <<= 1) { const float t = __shfl_up(inc, o); if (C.lane >= o) inc += t; }
    const float excl = inc - run;
    if (C.lane == 63) wsum[C.wave] = inc;
    __syncthreads();
    float pre = 0.f;
#pragma unroll
    for (int w = 0; w < 8; ++w) pre += (w < C.wave) ? wsum[w] : 0.f;
    if (act) {
#pragma unroll
        for (int k = 0; k < 4; ++k) kbl[s0 + k] = -(pre + excl + c[k]) * LOG2E; }
    __syncthreads();
}
template <int G> __device__ __forceinline__ void pool_unit(const Ctx& C, const Args& A, int l, int blk) {
    constexpr int W = 2 << G;
    const bf16* proj = (const bf16*)(C.ws + WS_A); bf16* mix = (bf16*)(C.ws + WS_C); const bf16* pt = (const bf16*)(C.ws + WS_PT) + G * 16384;
    LAS unsigned char* Wt = C.lds; LAS unsigned char* At = C.lds + 36864 + C.wave * 8704;
    const int tid = C.tid, lane = C.lane;
#pragma unroll
    for (int i = 0; i < 4; ++i) { const int ch = tid + 512 * i, row = ch >> 4, cc = ch & 15; *(LAS v4u*)(Wt + row * 272 + cc * 16) = *(const GAS v4u*)(pt + row * 128 + cc * 8); }
    const int t0 = blk * 256 + C.wave * 32, tt0 = t0 & (SEQ - 1); const int col = PC_PU + G * 128 + 2 * lane;
    float Pa[49], Pb[49]; Pa[0] = 0.f; Pb[0] = 0.f;
#pragma unroll
    for (int k = 0; k < 48; ++k) { const int j = k - 16; float ua = 0.f, ub = 0.f;
        if (tt0 + j >= 0) { const unsigned w = *(const GAS unsigned*)(proj + (size_t)(t0 + j) * NPROJ + col); ua = bflo(w); ub = bfhi(w); }
        Pa[k + 1] = Pa[k] + ua; Pb[k + 1] = Pb[k] + ub; }
#pragma unroll
    for (int j = 0; j < 32; ++j) { const int tt = tt0 + j; const float cn = (float)(tt + 1 < W ? tt + 1 : W);
        const float pa = (Pa[j + 17] - Pa[j + 17 - W]) / cn - (Pa[j + 17] - Pa[j + 16]), pb = (Pb[j + 17] - Pb[j + 17 - W]) / cn - (Pb[j + 17] - Pb[j + 16]);
        *(LAS unsigned*)(At + j * 272 + lane * 4) = pk2(pa, pb); }
    __syncthreads();
    typedef float f32x16 __attribute__((ext_vector_type(16)));
    f32x16 acc[4];
#pragma unroll
    for (int nb = 0; nb < 4; ++nb) acc[nb] = f32x16{};
    const int r32 = lane & 31, hi = lane >> 5;
#pragma unroll
    for (int ks = 0; ks < 8; ++ks) { const bf16x8 a = *(const LAS bf16x8*)(At + r32 * 272 + (16 * ks + 8 * hi) * 2);
#pragma unroll
        for (int nb = 0; nb < 4; ++nb) { const bf16x8 bb = *(const LAS bf16x8*)(Wt + (32 * nb + r32) * 272 + (16 * ks + 8 * hi) * 2); acc[nb] = __builtin_amdgcn_mfma_f32_32x32x16_bf16(a, bb, acc[nb], 0, 0, 0); } }
    const float* sc = A.in[I_POOLS] + l * 512 + G * 128;
#pragma unroll
    for (int nb = 0; nb < 4; ++nb) { const float s = sc[32 * nb + r32];
#pragma unroll
        for (int r = 0; r < 16; ++r) { const int row = (r & 3) + 8 * (r >> 2) + 4 * hi; mix[(size_t)(t0 + row) * DM + 1024 + G * 128 + 32 * nb + r32] = (bf16)f2bf(acc[nb][r] * s); } }
    __syncthreads();
}
__device__ __forceinline__ void ph_mixer(const Ctx& C0, const Args& A, int l, char* lds_generic) {
    unsigned char* ws = C0.ws; const bf16* proj = (const bf16*)(ws + WS_A); bf16* mix = (bf16*)(ws + WS_C); bf16* dscr = (bf16*)(ws + WS_DSCR);
    const float* tbl = (const float*)(ws + WS_TBL); unsigned* que = (unsigned*)(ws + WS_CTL) + CW_QUE + 64 * l;
    volatile LAS unsigned* qw = (volatile LAS unsigned*)(C0.lds + TAB_OFF + 128);
    LAS float* dtl = (LAS float*)(C0.lds + MX_DTL);
    const attn_body::lds_fptr kblp = (attn_body::lds_fptr)(C0.lds + MX_KBL), dtlp = (attn_body::lds_fptr)(C0.lds + MX_DTL);
    typedef attn_body::bf16 abf;
    for (;;) {
        Ctx C = C0; C.lane = lane_id_opaque(); C.tid = C.wave * 64 + C.lane;
        __syncthreads();
        if (C.tid == 0) qw[0] = atomicAdd(que, 1u);
        __syncthreads();
        const int idx = (int)__builtin_amdgcn_readfirstlane(qw[0]);
        if (idx >= MX_NUNITS) break;
        if (idx < 768) { const int qb = 7 - idx / 96, rem = idx % 96;
            if (rem < 32) { if (FASTMASK & 1) { const int b = rem >> 3, h = rem & 7;
                fox_scan(C, proj, b, h, qb * 256 + 256, A.in[I_BF][l * 8 + h]);
                const bf16* pb_ = proj + (size_t)b * SEQ * NPROJ;
                attn_body::attn_unit<attn_body::M_KB, 8>((const abf*)(pb_ + PC_FQ + h * 64), (const abf*)(pb_ + PC_FK + h * 64), (const abf*)(pb_ + PC_FV + h * 64), (abf*)(mix + (size_t)b * SEQ * DM + h * 64), DM, qb * 256, 0, 4 * qb + 4, kblp, dtlp, 0.f, lds_generic, C.wave); }
            } else if (FASTMASK & 2) { const int r2 = rem - 32, b = r2 >> 4, hh = r2 & 15, h = hh >> 2, m = (hh >> 1) & 1, half = hh & 1;
                if (C.tid < 129) dtl[C.tid] = tbl[h * 129 + C.tid] - tbl[h * 129 + 128];
                __syncthreads();
                const bf16* pb_ = proj + (size_t)b * SEQ * NPROJ;
                attn_body::attn_unit<attn_body::M_DIST, 8>((const abf*)(pb_ + PC_DQ + (h * 2 + m) * 64), (const abf*)(pb_ + PC_DK + (h * 2 + m) * 64), (const abf*)(pb_ + PC_DV + h * 128 + half * 64), (abf*)(dscr + (size_t)b * SEQ * 1024 + m * 512 + h * 128 + half * 64), 1024, qb * 256, 0, 4 * qb + 4, kblp, dtlp, 0.f, lds_generic, C.wave);
            }
        } else if (idx < 1024) { if (FASTMASK & 4) { const int r = idx - 768, qb = 7 - (r >> 5), b = (r & 31) >> 3, h = r & 7;
            if (C.tid < 129) dtl[C.tid] = tbl[(4 + h) * 129 + C.tid];
            __syncthreads();
            const bf16* pb_ = proj + (size_t)b * SEQ * NPROJ;
            attn_body::attn_unit<attn_body::M_DIST | attn_body::M_WIN, 8>((const abf*)(pb_ + PC_SQ + h * 64), (const abf*)(pb_ + PC_SK + (h >> 2) * 64), (const abf*)(pb_ + PC_SV + (h >> 2) * 64), (abf*)(mix + (size_t)b * SEQ * DM + 1536 + h * 64), DM, qb * 256, qb ? 4 * qb - 2 : 0, qb ? 6 : 4, kblp, dtlp, A.in[I_SINK][l * 8 + h] * LOG2E, lds_generic, C.wave); }
        } else if (FASTMASK & 8) { const int r = idx - 1024, blk = r >> 2, g = r & 3;
            if (g == 0) pool_unit<0>(C, A, l, blk); else if (g == 1) pool_unit<1>(C, A, l, blk); else if (g == 2) pool_unit<2>(C, A, l, blk); else pool_unit<3>(C, A, l, blk);
        }
    }
}
__device__ __forceinline__ void ph_combine(const Ctx& C0, const Args& A, int l) {
    Ctx C = C0; C.lane = lane_id_opaque(); C.tid = C.wave * 64 + C.lane;

    unsigned char* ws = C.ws; bf16* mix = (bf16*)(ws + WS_C); const bf16* dscr = (const bf16*)(ws + WS_DSCR); const int lane = C.lane;
    const float lam_init = (l == 0) ? 0.2f : 0.35550907f;
    const float s1 = wave_sum(A.in[I_LQ1][l * 64 + lane] * A.in[I_LK1][l * 64 + lane]), s2 = wave_sum(A.in[I_LQ2][l * 64 + lane] * A.in[I_LK2][l * 64 + lane]);
    const float lam = expf(s1) - expf(s2) + lam_init;
    const float g0 = A.in[I_DNG][l * 128 + 2 * lane], g1 = A.in[I_DNG][l * 128 + 2 * lane + 1];
    if (FASTMASK & 2) for (int u = C.gw; u < 4 * TOK; u += C.NGW) { const int h = u & 3, t = u >> 2;
        const unsigned a = *(const GAS unsigned*)(dscr + (size_t)t * 1024 + h * 128 + 2 * lane), b = *(const GAS unsigned*)(dscr + (size_t)t * 1024 + 512 + h * 128 + 2 * lane);
        const float d0 = bflo(a) - lam * bflo(b), d1 = bfhi(a) - lam * bfhi(b);
        const float ms = wave_sum(d0 * d0 + d1 * d1) * (1.f / 128.f); const float r = 1.f / sqrtf(ms + LN_EPS) * (1.f - lam_init);
        *(GAS unsigned*)(mix + (size_t)t * DM + 512 + h * 128 + 2 * lane) = pk2(d0 * r * g0, d1 * r * g1); }
}

__device__ __forceinline__ void ln_row(const float* zrow, const float* g, const float* bb, float* hrow, bf16* hbrow, f32x4 (&v)[8], int lane) {
    const GAS f32x4* zr = (const GAS f32x4*)zrow + lane; float s = 0.f;
#pragma unroll
    for (int j = 0; j < 8; ++j) { v[j] = zr[64 * j]; s += (v[j].x + v[j].y) + (v[j].z + v[j].w); }
    const float mean = wave_sum(s) * (1.f / DM); float s2 = 0.f;
#pragma unroll
    for (int j = 0; j < 8; ++j) { v[j] = v[j] - mean; s2 += (v[j].x * v[j].x + v[j].y * v[j].y) + (v[j].z * v[j].z + v[j].w * v[j].w); }
    const float rstd = 1.f / sqrtf(wave_sum(s2) * (1.f / DM) + LN_EPS);
#pragma unroll
    for (int j = 0; j < 8; ++j) { const f32x4 gg = *((const f32x4*)g + lane + 64 * j), bv = *((const f32x4*)bb + lane + 64 * j); v[j] = v[j] * rstd * gg + bv;
        *((GAS f32x4*)hrow + lane + 64 * j) = v[j];
        *((GAS unsigned long long*)hbrow + lane + 64 * j) = (unsigned long long)pk2(v[j].x, v[j].y) | ((unsigned long long)pk2(v[j].z, v[j].w) << 32); }
}
__device__ __forceinline__ void ph_ln1_router(const Ctx& C0, const Args& A, int l) {
    Ctx C = C0; C.lane = lane_id_opaque(); C.tid = C.wave * 64 + C.lane;
    unsigned char* ws = C.ws; const float* z = (const float*)(ws + WS_A); float* hf = (float*)(ws + WS_H); bf16* hb = (bf16*)(ws + WS_HB);
    const float* wrt = (const float*)(ws + WS_WRT); unsigned* cnt = (unsigned*)(ws + WS_CTL) + CW_CNT + 1024 * l;
    int* ltok = (int*)(ws + WS_LTOK); float* lw = (float*)(ws + WS_LW); int* toke = (int*)(ws + WS_TOKE); int* tokp = (int*)(ws + WS_TOKP);
    const int lane = C.lane, tid = C.tid, wave = C.wave; const float* g = A.in[I_LN1G] + l * DM; const float* bb = A.in[I_LN1B] + l * DM;
    LAS float* part = (LAS float*)(C.lds + RING_OFF);
    LAS float* lgs = (LAS float*)(C.lds + RING_OFF + 32768);
    for (int tb = C.vcu; tb < TOK / 32; tb += C.G) {
#pragma unroll 1
        for (int r = 0; r < 4; ++r) { const int t = tb * 32 + wave * 4 + r; f32x4 v[8]; ln_row(z + (size_t)t * DM, g, bb, hf + (size_t)t * DM, hb + (size_t)t * DM, v, lane); }
        asm volatile("s_waitcnt vmcnt(0)" ::: "memory");
        __syncthreads();
        { typedef float f32x16 __attribute__((ext_vector_type(16)));
          f32x16 acc = f32x16{};
          const int r32 = lane & 31, hi = lane >> 5; const bool colok = r32 < 20;
          const float* arow = hf + (size_t)(tb * 32 + r32) * DM + 256 * wave + 4 * hi;
          const float* brow = wrt + (size_t)(colok ? r32 : 0) * DM + 256 * wave + 4 * hi;
#pragma unroll 8
          for (int s8 = 0; s8 < 32; ++s8) { const f32x4 a = *(const GAS f32x4*)(arow + 8 * s8); f32x4 b = *(const GAS f32x4*)(brow + 8 * s8); if (!colok) b = (f32x4){0.f, 0.f, 0.f, 0.f};
              acc = __builtin_amdgcn_mfma_f32_32x32x2f32(a.x, b.x, acc, 0, 0, 0); acc = __builtin_amdgcn_mfma_f32_32x32x2f32(a.y, b.y, acc, 0, 0, 0);
              acc = __builtin_amdgcn_mfma_f32_32x32x2f32(a.z, b.z, acc, 0, 0, 0); acc = __builtin_amdgcn_mfma_f32_32x32x2f32(a.w, b.w, acc, 0, 0, 0); }
          if (colok) {
#pragma unroll
              for (int r = 0; r < 16; ++r) part[(wave * 32 + (r & 3) + 8 * (r >> 2) + 4 * hi) * 20 + r32] = acc[r]; }
        }
        __syncthreads();
        for (int i = tid; i < 640; i += 512) { float s = 0.f;
#pragma unroll
            for (int wv = 0; wv < 8; ++wv) s += part[wv * 640 + i];
            lgs[i] = s; }
        __syncthreads();
        if (tid < 32) { const int t = tb * 32 + tid; const LAS float* lg = lgs + tid * 20;
            const float* rgb = A.in[I_RGB] + l * 4; const float* reb = A.in[I_REB] + l * 16;
            const float q0 = lg[0] + rgb[0], q1 = lg[1] + rgb[1], q2 = lg[2] + rgb[2], q3 = lg[3] + rgb[3];
            int gs = 0; float gm = q0;
            if (q1 > gm) { gm = q1; gs = 1; }
            if (q2 > gm) { gm = q2; gs = 2; }
            if (q3 > gm) { gm = q3; gs = 3; }
            const float gp = 1.f / (expf(q0 - gm) + expf(q1 - gm) + expf(q2 - gm) + expf(q3 - gm));
            const float c0 = lg[4 + gs * 4 + 0] + reb[gs * 4 + 0], c1 = lg[4 + gs * 4 + 1] + reb[gs * 4 + 1], c2 = lg[4 + gs * 4 + 2] + reb[gs * 4 + 2], c3 = lg[4 + gs * 4 + 3] + reb[gs * 4 + 3];
            int i1 = 0; float v1 = c0;
            if (c1 > v1) { v1 = c1; i1 = 1; }
            if (c2 > v1) { v1 = c2; i1 = 2; }
            if (c3 > v1) { v1 = c3; i1 = 3; }
            int i2 = -1; float v2 = -INFINITY;
            if (i1 != 0 && c0 > v2) { v2 = c0; i2 = 0; }
            if (i1 != 1 && c1 > v2) { v2 = c1; i2 = 1; }
            if (i1 != 2 && c2 > v2) { v2 = c2; i2 = 2; }
            if (i1 != 3 && c3 > v2) { v2 = c3; i2 = 3; }
            const float ex = expf(v2 - v1); const float w1 = gp / (1.f + ex), w2 = gp * ex / (1.f + ex);
            const int e1 = gs * 4 + i1, e2 = gs * 4 + i2;
            LAS unsigned* lc = (LAS unsigned*)(C.lds + RING_OFF + 36864);
            if (tid < 16) lc[tid] = 0u;
            const unsigned r1 = __hip_atomic_fetch_add(lc + e1, 1u, __ATOMIC_RELAXED, __HIP_MEMORY_SCOPE_WORKGROUP), r2 = __hip_atomic_fetch_add(lc + e2, 1u, __ATOMIC_RELAXED, __HIP_MEMORY_SCOPE_WORKGROUP);
            if (tid < 16) { const unsigned n = lc[tid]; lc[16 + tid] = n ? atomicAdd(cnt + 64 * tid, n) : 0u; }
            const unsigned p1 = lc[16 + e1] + r1, p2 = lc[16 + e2] + r2;
            ltok[e1 * 8192 + p1] = t; lw[e1 * 8192 + p1] = w1; ltok[e2 * 8192 + p2] = t; lw[e2 * 8192 + p2] = w2;
            toke[t * 2] = e1; toke[t * 2 + 1] = e2; tokp[t * 2] = (int)p1; tokp[t * 2 + 1] = (int)p2;
        }
        __syncthreads();
    }
}
__device__ __forceinline__ void build_ts(const Ctx& C, int l) {
    const bool lead = C.wave == 0 && lane_id_opaque() == 0;
    LAS int* ts = (LAS int*)(C.lds + TAB_OFF); const unsigned* cnt = (const unsigned*)(C.ws + WS_CTL) + CW_CNT + 1024 * l;
    __syncthreads();
    if (lead) { int acc = 0; for (int e = 0; e < 16; ++e) { ts[e] = acc; acc += ((int)__hip_atomic_load(cnt + 64 * e, __ATOMIC_RELAXED, __HIP_MEMORY_SCOPE_AGENT) + 255) >> 8; } ts[16] = acc; }
    __syncthreads();
}
__device__ __forceinline__ void ph_gather(const Ctx& C0, const Args& A, int l) {
    Ctx C = C0; C.lane = lane_id_opaque(); C.tid = C.wave * 64 + C.lane;

    build_ts(C, l);
    const LAS int* ts = (const LAS int*)(C.lds + TAB_OFF); const unsigned* cnt = (const unsigned*)(C.ws + WS_CTL) + CW_CNT + 1024 * l;
    const int* ltok = (const int*)(C.ws + WS_LTOK); const bf16* hb = (const bf16*)(C.ws + WS_HB); bf16* hp = (bf16*)(C.ws + WS_A);
    const int nslot = ts[16] * 256;
    for (int s = C.gw; s < nslot; s += C.NGW) { const int rt = s >> 8; int e = 0;
#pragma unroll
        for (int j = 1; j < 16; ++j) e += (ts[j] <= rt) ? 1 : 0;
        const int pos = s - ts[e] * 256; GAS v4u* d = (GAS v4u*)(hp + (size_t)s * DM) + C.lane;
        if (pos < (int)cnt[64 * e]) { const int t = ltok[e * 8192 + pos]; const GAS v4u* sp = (const GAS v4u*)(hb + (size_t)t * DM) + C.lane;
#pragma unroll
            for (int j = 0; j < 4; ++j) d[64 * j] = sp[64 * j]; }
        else {
#pragma unroll
            for (int j = 0; j < 4; ++j) d[64 * j] = (v4u){0u, 0u, 0u, 0u}; }
    }
}
__device__ __forceinline__ void ph_ln2(const Ctx& C0, const Args& A, int l) {
    Ctx C = C0; C.lane = lane_id_opaque(); C.tid = C.wave * 64 + C.lane;

    build_ts(C, l);
    const LAS int* ts = (const LAS int*)(C.lds + TAB_OFF);
    unsigned char* ws = C.ws; const float* hf = (const float*)(ws + WS_H); const bf16* ys = (const bf16*)(ws + WS_A); const bf16* ple = (const bf16*)(ws + WS_PLE);
    const int* toke = (const int*)(ws + WS_TOKE); const int* tokp = (const int*)(ws + WS_TOKP); bf16* xb = (bf16*)(ws + WS_XB);
    const int lane = C.lane; const float* g = A.in[I_LN2G] + l * DM; const float* bb = A.in[I_LN2B] + l * DM;
    for (int t = C.gw; t < TOK; t += C.NGW) {
        const int e1 = toke[t * 2], e2 = toke[t * 2 + 1]; const int s1 = ts[e1] * 256 + tokp[t * 2], s2 = ts[e2] * 256 + tokp[t * 2 + 1];
        f32x4 v[8]; float s = 0.f;
#pragma unroll
        for (int j = 0; j < 8; ++j) { const f32x4 hv = *((const GAS f32x4*)(hf + (size_t)t * DM) + lane + 64 * j);
            const unsigned long long a = *((const GAS unsigned long long*)(ys + (size_t)s1 * DM) + lane + 64 * j), b = *((const GAS unsigned long long*)(ys + (size_t)s2 * DM) + lane + 64 * j), c = *((const GAS unsigned long long*)(ple + (size_t)t * DM) + lane + 64 * j);
            const unsigned a0 = (unsigned)a, a1 = (unsigned)(a >> 32), b0 = (unsigned)b, b1 = (unsigned)(b >> 32), c0 = (unsigned)c, c1 = (unsigned)(c >> 32);
            v[j].x = ALPHA * hv.x + (bflo(a0) + bflo(b0)) + bflo(c0); v[j].y = ALPHA * hv.y + (bfhi(a0) + bfhi(b0)) + bfhi(c0);
            v[j].z = ALPHA * hv.z + (bflo(a1) + bflo(b1)) + bflo(c1); v[j].w = ALPHA * hv.w + (bfhi(a1) + bfhi(b1)) + bfhi(c1);
            s += (v[j].x + v[j].y) + (v[j].z + v[j].w); }
        const float mean = wave_sum(s) * (1.f / DM); float q = 0.f;
#pragma unroll
        for (int j = 0; j < 8; ++j) { v[j] = v[j] - mean; q += (v[j].x * v[j].x + v[j].y * v[j].y) + (v[j].z * v[j].z + v[j].w * v[j].w); }
        const float rstd = 1.f / sqrtf(wave_sum(q) * (1.f / DM) + LN_EPS);
#pragma unroll
        for (int j = 0; j < 8; ++j) { const f32x4 gg = *((const f32x4*)g + lane + 64 * j), bv = *((const f32x4*)bb + lane + 64 * j); v[j] = v[j] * rstd * gg + bv;
            *((GAS f32x4*)(C.out + (size_t)t * DM) + lane + 64 * j) = v[j];
            if (l == 0) *((GAS unsigned long long*)(xb + (size_t)t * DM) + lane + 64 * j) = (unsigned long long)pk2(v[j].x, v[j].y) | ((unsigned long long)pk2(v[j].z, v[j].w) << 32); }
    }
}

constexpr int NPHASE = 1 + 2 * 9;
#ifndef MK_PER_PHASE
#define MK_PER_PHASE 0
#endif
__global__ void __launch_bounds__(NWAVES * 64, 2) mk_fwd(Args args) {
    extern __shared__ __attribute__((aligned(16))) unsigned char lds_raw[];
    Ctx C;
    C.lds = (LAS unsigned char*)lds_raw;
    C.G = gridDim.x; { const int bx = blockIdx.x; C.vcu = (C.G % 8 == 0) ? (bx % 8) * (C.G / 8) + bx / 8 : bx; }
    C.NGW = C.G * NWAVES; C.ws = args.ws; C.out = args.out; C.wave = __builtin_amdgcn_readfirstlane(threadIdx.x >> 6); C.gw = C.vcu * NWAVES + C.wave;
    { const int t0 = threadIdx.x; for (int u = t0; u < (LDS_BYTES - LDSCTL_OFF) / 4; u += NWAVES * 64) ((LAS unsigned*)(C.lds + LDSCTL_OFF))[u] = 0u; }
    __syncthreads();
    const bool multi = (args.ph_hi - args.ph_lo) > 1;
    XcdBarrier bar; bar.bar = (unsigned*)(args.ws + WS_CTL) + CW_BAR; bar.x = 0; bar.st = nullptr;
    if (multi) bar = xcd_barrier_post((unsigned*)(args.ws + WS_CTL) + CW_BAR, (volatile LAS unsigned*)(C.lds + MISC_OFF) + 8);
    bar.wv = C.wave;

    for (int it = args.ph_lo; it < args.ph_hi; ++it) {
        unsigned char* ws = args.ws; asm volatile("" : "+s"(ws)); C.ws = ws;
        const unsigned long long sw_ = it < 8 ? args.seq0 : it < 16 ? args.seq1 : it < 24 ? args.seq2 : args.seq3;
        const int se_ = (int)((sw_ >> ((it & 7) * 8)) & 0xffu); const int ph = se_ & 63;
        if (se_ & 64) {
            const int kk_ = (ph - 1) % 9;
            const int ptid_ = C.wave * 64 + lane_id_opaque();
            if (blockIdx.x == 0 && ptid_ < 16) { const int l_ = (ph - 1) / 9; unsigned* ctl = (unsigned*)(ws + WS_CTL);
                if (kk_ == 4) __hip_atomic_store(ctl + CW_CNT + 1024 * l_ + 64 * ptid_, 0u, __ATOMIC_RELAXED, __HIP_MEMORY_SCOPE_AGENT);
                if (kk_ == 1 && ptid_ == 0) __hip_atomic_store(ctl + CW_QUE + 64 * l_, 0u, __ATOMIC_RELAXED, __HIP_MEMORY_SCOPE_AGENT); }
            xcd_barrier(bar);
        }
        const int l = ph == 0 ? 0 : (ph - 1) / 9, k = ph == 0 ? -1 : (ph - 1) % 9;
        if (k == -1) { ph_prologue(C, args); }
        else if (k == 0) {
            for (int sub = 0; sub < 2; ++sub) {
                pg8::Gemm g; pg8::StaticOrder S; pg8::EpiBf16<0> E;
                if (sub == 0) { g = pg8::Gemm{(const pg8::bf16_t*)(ws + WS_XB), (const pg8::bf16_t*)(ws + WS_WIN), TOK, NPROJ, DM}; S.init(TOK, NPROJ, C.G, (int)blockIdx.x); E = pg8::EpiBf16<0>{(pg8::bf16_t*)(ws + WS_A), NPROJ, nullptr, 0, 0, 1.f}; }
                else { g = pg8::Gemm{(const pg8::bf16_t*)(ws + WS_PB), (const pg8::bf16_t*)(ws + WS_WU), TOK, DM, PLED}; S.init(TOK, DM, C.G, (int)blockIdx.x); E = pg8::EpiBf16<0>{(pg8::bf16_t*)(ws + WS_U), DM, nullptr, 0, 0, 1.f}; }
                pg8::gemm_phase<pg8::EpiBf16<0>, pg8::StaticOrder, true, true>(C.lds + RING_OFF, g, S, E, C.wave);
            }
            conv_drain(C, args, l == 0 ? 1 : 3);
        }
        else if (k == 1) { ph_mixer(C, args, l, (char*)lds_raw); }
        else if (k == 2) { ph_combine(C, args, l); }
        else if (k == 3) {
            pg8::Gemm g{(const pg8::bf16_t*)(ws + WS_C), (const pg8::bf16_t*)(ws + WS_WO), TOK, DM, DM}; pg8::StaticOrder S; S.init(TOK, DM, C.G, (int)blockIdx.x);
            pg8::EpiResF32 E{l == 0 ? args.in[I_X] : (const float*)args.out, (float*)(ws + WS_A), DM, ALPHA};
            pg8::gemm_phase<pg8::EpiResF32, pg8::StaticOrder, true, true>(C.lds + RING_OFF, g, S, E, C.wave);
        }
        else if (k == 4) { ph_ln1_router(C, args, l); }
        else if (k == 5) { ph_gather(C, args, l); }
        else if (k == 6) {
            build_ts(C, l);
            pg8::Gemm g{(const pg8::bf16_t*)(ws + WS_A), (const pg8::bf16_t*)(ws + WS_W1), SLOTS, NEXP * 1024, DM};
            pg8::MoeOrder S{(const LAS int*)(C.lds + TAB_OFF), 4, C.G, (int)blockIdx.x};
            pg8::EpiSwiglu E{(pg8::bf16_t*)(ws + WS_C), (const float*)(ws + WS_LW), (const int*)((const unsigned*)(ws + WS_CTL) + CW_CNT + 1024 * l), (const LAS int*)(C.lds + TAB_OFF)};
            pg8::gemm_phase<pg8::EpiSwiglu, pg8::MoeOrder, true, true>(C.lds + RING_OFF, g, S, E, C.wave);
            conv_drain(C, args, l == 0 ? 2 : 4);
        }
        else if (k == 7) {
            build_ts(C, l);
            { pg8::Gemm g{(const pg8::bf16_t*)(ws + WS_C), (const pg8::bf16_t*)(ws + WS_WD), SLOTS, NEXP * DM, DEXP};
              pg8::MoeOrder S{(const LAS int*)(C.lds + TAB_OFF), 8, C.G, (int)blockIdx.x};
              pg8::EpiStore E{(pg8::bf16_t*)(ws + WS_A), DM, 7};
              pg8::gemm_phase<pg8::EpiStore, pg8::MoeOrder, true, true>(C.lds + RING_OFF, g, S, E, C.wave); }
            { pg8::Gemm g{(const pg8::bf16_t*)(ws + WS_HB), (const pg8::bf16_t*)(ws + WS_WG), TOK, DM, DM}; pg8::StaticOrder S; S.init(TOK, DM, C.G, (int)blockIdx.x);
              pg8::EpiPle E{(const pg8::bf16_t*)(ws + WS_U), (pg8::bf16_t*)(ws + WS_PLE), DM};
              pg8::gemm_phase<pg8::EpiPle, pg8::StaticOrder, true, true>(C.lds + RING_OFF, g, S, E, C.wave); }
        }
        else { ph_ln2(C, args, l); }
        if (it + 1 < args.ph_hi) xcd_barrier(bar);
    }
}

extern "C" void kernel_launch(void* const* d_in, const int* in_sizes, int n_in, void* d_out, int out_size, void* d_ws, size_t ws_size, hipStream_t stream) {
    static int grid = 0;
    if (grid == 0) {
        if (n_in != N_IN || out_size != TOK * DM || ws_size < WS_END) { fprintf(stderr, "kernel_launch: unexpected shapes n_in %d out %d ws %zu (need %zu)\n", n_in, out_size, ws_size, (size_t)WS_END); grid = -1; return; }
        int dev = 0, cus = 0;
        if (hipGetDevice(&dev) != hipSuccess || hipDeviceGetAttribute(&cus, hipDeviceAttributeMultiprocessorCount, dev) != hipSuccess) { grid = -1; return; }
        if (hipFuncSetAttribute((const void*)mk_fwd, hipFuncAttributeMaxDynamicSharedMemorySize, LDS_BYTES) != hipSuccess) { fprintf(stderr, "kernel_launch: hipFuncSetAttribute failed\n"); grid = -1; return; }
        (void)hipGetLastError();
        grid = cus;
    }
    if (grid < 0) return;
    if (hipMemsetAsync((char*)d_ws + WS_CTL, 0, CTL_ZERO_BYTES, stream) != hipSuccess) return;
    Args a{};
    for (int i = 0; i < N_IN; ++i) a.in[i] = (const float*)d_in[i];
    a.out = (float*)d_out; a.ws = (unsigned char*)d_ws;
#ifndef PROBE_K
#define PROBE_K -2
#endif
#ifndef PROBE_N
#define PROBE_N 0
#endif
    int n = 0; unsigned char seq[32] = {0};
    for (int ph = 0; ph < NPHASE; ++ph) { if (n < 32) seq[n++] = (unsigned char)ph; const int kk = ph == 0 ? -1 : (ph - 1) % 9;
        if (kk == PROBE_K) for (int r = 0; r < PROBE_N; ++r) if (n < 32) seq[n++] = (unsigned char)(ph | 64); }
    for (int i = 0; i < 8; ++i) { a.seq0 |= (unsigned long long)seq[i] << (8 * i); a.seq1 |= (unsigned long long)seq[8 + i] << (8 * i); a.seq2 |= (unsigned long long)seq[16 + i] << (8 * i); a.seq3 |= (unsigned long long)seq[24 + i] << (8 * i); }
#if MK_PER_PHASE
    for (int it = 0; it < n; ++it) { a.ph_lo = it; a.ph_hi = it + 1; hipLaunchKernelGGL(mk_fwd, dim3(grid), dim3(NWAVES * 64), LDS_BYTES, stream, a); }
#else
    a.ph_lo = 0; a.ph_hi = n;
    hipLaunchKernelGGL(mk_fwd, dim3(grid), dim3(NWAVES * 64), LDS_BYTES, stream, a);
#endif
}
```
